# Optimizing an MI355X kernel written in HIP

```python
import math
import jax
import jax.numpy as jnp
from jax import lax
import numpy as np

D_MODEL = 2048
BATCH = 2
SEQ = 4096
DEPTH = 1

GRID_W = 64
CTX_LEN = 256
NA_HEAD_DIM = 128
NA_HEADS = D_MODEL // (2 * NA_HEAD_DIM)
NA_WIN_H = 8
NA_WIN_W = 16
DIFF_HEAD_DIM = 64
DIFF_V_DIM = 2 * DIFF_HEAD_DIM
DIFF_HEADS = D_MODEL // (2 * DIFF_V_DIM)
NA_WIDTH = NA_HEADS * NA_HEAD_DIM
DIFF_QK_WIDTH = DIFF_HEADS * 2 * DIFF_HEAD_DIM
DIFF_V_WIDTH = DIFF_HEADS * DIFF_V_DIM
IN_CTX_COLS = 2 * NA_WIDTH + DIFF_QK_WIDTH + DIFF_V_WIDTH
IN_COLS = IN_CTX_COLS + NA_WIDTH + DIFF_QK_WIDTH + 2 * D_MODEL
Q_BLOCK = 128
ROPE_BASE = 10000.0
N_EXPERTS = 32
TOP_K = 4
D_FF = D_MODEL
SWIGLU_ALPHA = 1.702
SWIGLU_LIMIT = 7.0
MOE_BLOCK = 128
LN_EPS = 1e-6
RMS_EPS = 1e-5
DEEPNORM_ALPHA = (2 * DEPTH) ** 0.25
DEEPNORM_BETA = (8 * DEPTH) ** -0.25

kernel_name = 'hybrid_natten_diffattn_moe_dit_layer'


def _layernorm(x, w=None, b=None):
    xf = x.astype(jnp.float32)
    xc = xf - jnp.mean(xf, axis=-1, keepdims=True)
    y = xc * lax.rsqrt(jnp.mean(xc * xc, axis=-1, keepdims=True) + LN_EPS)
    if w is not None:
        y = y * w.astype(jnp.float32) + b.astype(jnp.float32)
    return y.astype(x.dtype)


def _modulate(x, shift, scale):
    return _layernorm(x) * (1 + scale) + shift


def _axial_rope(x, row_pos, col_pos):
    half = x.shape[-1] // 2
    n_freq = half // 2
    inv_freq = ROPE_BASE ** (-jnp.arange(n_freq, dtype=jnp.float32) / n_freq)
    xf = x.astype(jnp.float32)

    def rotate(xa, pos):
        ang = pos[:, None] * inv_freq[None, :]
        cos = jnp.cos(ang)[None, :, None, None, :]
        sin = jnp.sin(ang)[None, :, None, None, :]
        x1, x2 = xa[..., :n_freq], xa[..., n_freq:]
        return jnp.concatenate([x1 * cos - x2 * sin, x2 * cos + x1 * sin], axis=-1)

    out = jnp.concatenate([rotate(xf[..., :half], row_pos), rotate(xf[..., half:], col_pos)], axis=-1)
    return out.astype(x.dtype)


def _split_kv(p, b, n):
    o1 = NA_WIDTH
    o2 = 2 * NA_WIDTH
    o3 = o2 + DIFF_QK_WIDTH
    k_na = p[..., :o1].reshape(b, n, NA_HEADS, NA_HEAD_DIM)
    v_na = p[..., o1:o2].reshape(b, n, NA_HEADS, NA_HEAD_DIM)
    k_df = p[..., o2:o3].reshape(b, n, DIFF_HEADS, 2, DIFF_HEAD_DIM)
    v_df = p[..., o3:IN_CTX_COLS].reshape(b, n, DIFF_HEADS, DIFF_V_DIM)
    return k_na, v_na, k_df, v_df


def _split_qg(p, b, n):
    o1 = NA_WIDTH
    o2 = o1 + DIFF_QK_WIDTH
    o3 = o2 + D_MODEL
    q_na = p[..., :o1].reshape(b, n, NA_HEADS, NA_HEAD_DIM)
    q_df = p[..., o1:o2].reshape(b, n, DIFF_HEADS, 2, DIFF_HEAD_DIM)
    return q_na, q_df, p[..., o2:o3], p[..., o3:]


def _neighbourhood_attention(q, k, v, k_ctx, v_ctx, rel_bias):
    b, s, h, hd = q.shape
    rows = s // GRID_W
    win_h = min(NA_WIN_H, rows)
    n_loc = win_h * NA_WIN_W
    scale = hd ** -0.5
    qg = q.reshape(b, rows, GRID_W, h, hd)
    kg = k.reshape(b, rows, GRID_W, h, hd)
    vg = v.reshape(b, rows, GRID_W, h, hd)
    col = np.arange(GRID_W)
    col_start = np.clip(col - NA_WIN_W // 2, 0, GRID_W - NA_WIN_W)
    col_idx = col_start[:, None] + np.arange(NA_WIN_W)[None, :]
    col_off = col_idx - col[:, None] + (NA_WIN_W - 1)

    def row_block(r):
        r0 = jnp.clip(r - win_h // 2, 0, rows - win_h)
        q_r = lax.dynamic_index_in_dim(qg, r, axis=1, keepdims=False)
        k_win = lax.dynamic_slice_in_dim(kg, r0, win_h, axis=1)[:, :, col_idx]
        v_win = lax.dynamic_slice_in_dim(vg, r0, win_h, axis=1)[:, :, col_idx]
        row_off = r0 + jnp.arange(win_h) - r + (NA_WIN_H - 1)
        bias = rel_bias[:, row_off[None, :, None], col_off[:, None, :]]
        s_loc = jnp.einsum('bqhd,biqjhd->bhqij', q_r, k_win).astype(jnp.float32) * scale
        s_loc = s_loc + bias.astype(jnp.float32)[None]
        s_ctx = jnp.einsum('bqhd,bchd->bhqc', q_r, k_ctx).astype(jnp.float32) * scale
        logits = jnp.concatenate([s_loc.reshape(b, h, GRID_W, n_loc), s_ctx], axis=-1)
        p = jax.nn.softmax(logits, axis=-1).astype(v.dtype)
        p_loc = p[..., :n_loc].reshape(b, h, GRID_W, win_h, NA_WIN_W)
        p_ctx = p[..., n_loc:]
        return (jnp.einsum('bhqij,biqjhd->bqhd', p_loc, v_win)
                + jnp.einsum('bhqc,bchd->bqhd', p_ctx, v_ctx))

    out = lax.map(row_block, jnp.arange(rows))
    return jnp.moveaxis(out, 0, 1).reshape(b, s, h * hd)


def _softmax_attention(q, k, v):
    s = jnp.einsum('bqhd,bkhd->bhqk', q, k).astype(jnp.float32) * q.shape[-1] ** -0.5
    p = jax.nn.softmax(s, axis=-1).astype(v.dtype)
    return jnp.einsum('bhqk,bkhd->bqhd', p, v)


def _diff_core(q, k, v, lam):
    s = jnp.einsum('bqhmd,bkhmd->bhmqk', q, k).astype(jnp.float32) * q.shape[-1] ** -0.5
    p = jax.nn.softmax(s, axis=-1)
    w = (p[:, :, 0] - lam * p[:, :, 1]).astype(v.dtype)
    return jnp.einsum('bhqk,bkhd->bqhd', w, v)


def _differential_attention_latent(q, k, v, k_ctx, v_ctx, lam):
    b, s = q.shape[:2]
    k_all = jnp.concatenate([k, k_ctx], axis=1)
    v_all = jnp.concatenate([v, v_ctx], axis=1)
    qb = jnp.moveaxis(q.reshape(b, s // Q_BLOCK, Q_BLOCK, DIFF_HEADS, 2, DIFF_HEAD_DIM), 1, 0)
    out = lax.map(lambda qq: _diff_core(qq, k_all, v_all, lam), qb)
    return jnp.moveaxis(out, 0, 1).reshape(b, s, DIFF_HEADS, DIFF_V_DIM)


def _diff_lambda(lq1, lk1, lq2, lk2, lam_init):
    f = jnp.float32
    return (jnp.exp(jnp.sum(lq1.astype(f) * lk1.astype(f)))
            - jnp.exp(jnp.sum(lq2.astype(f) * lk2.astype(f))) + lam_init)


def _diff_head_norm(o, w, lam_init):
    b, n = o.shape[:2]
    of = o.astype(jnp.float32)
    y = of * lax.rsqrt(jnp.mean(of * of, axis=-1, keepdims=True) + RMS_EPS)
    y = y * w.astype(jnp.float32) * (1.0 - lam_init)
    return y.reshape(b, n, DIFF_V_WIDTH).astype(o.dtype)


def _merge_branches(o_na, o_df, g_na, g_df, w_proj_na, w_proj_diff, w_out):
    y = jax.nn.sigmoid(g_na) * (o_na @ w_proj_na) + jax.nn.sigmoid(g_df) * (o_df @ w_proj_diff)
    return y @ w_out


def _token_mixer(u, uc, w_in, rel_bias, lam, lam_init, subln_w, w_proj_na, w_proj_diff, w_out,
                 row_pos, col_pos, ctx_out):
    b, s, _ = u.shape
    cl = uc.shape[1]
    p = u @ w_in
    k_na, v_na, k_df, v_df = _split_kv(p[..., :IN_CTX_COLS], b, s)
    q_na, q_df, g_na, g_df = _split_qg(p[..., IN_CTX_COLS:], b, s)
    pc = uc @ (w_in if ctx_out else w_in[:, :IN_CTX_COLS])
    k_na_c, v_na_c, k_df_c, v_df_c = _split_kv(pc[..., :IN_CTX_COLS], b, cl)
    q_df = _axial_rope(q_df, row_pos, col_pos)
    k_df = _axial_rope(k_df, row_pos, col_pos)
    o_na = _neighbourhood_attention(q_na, k_na, v_na, k_na_c, v_na_c, rel_bias)
    o_df = _diff_head_norm(_differential_attention_latent(q_df, k_df, v_df, k_df_c, v_df_c, lam),
                           subln_w, lam_init)
    y = _merge_branches(o_na, o_df, g_na, g_df, w_proj_na, w_proj_diff, w_out)
    if not ctx_out:
        return y, None
    q_na_c, q_df_c, g_na_c, g_df_c = _split_qg(pc[..., IN_CTX_COLS:], b, cl)
    o_na_c = _softmax_attention(q_na_c, k_na_c, v_na_c).reshape(b, cl, NA_WIDTH)
    o_df_c = _diff_head_norm(_diff_core(q_df_c, k_df_c, v_df_c, lam), subln_w, lam_init)
    yc = _merge_branches(o_na_c, o_df_c, g_na_c, g_df_c, w_proj_na, w_proj_diff, w_out)
    return y, yc


def _moe_ffn(u, w_router, b_router, w_gate, b_gate, w_up, b_up, w_down, b_down):
    t, d = u.shape
    logits = (u @ w_router + b_router).astype(jnp.float32)
    top_logit, top_e = lax.top_k(logits, TOP_K)
    top_w = jax.nn.softmax(top_logit, axis=-1)
    n_assign = t * TOP_K
    flat_e = top_e.reshape(n_assign)
    order = jnp.argsort(flat_e)
    sorted_e = flat_e[order]
    counts = jnp.zeros((N_EXPERTS,), jnp.int32).at[flat_e].add(1)
    padded = (counts + MOE_BLOCK - 1) // MOE_BLOCK * MOE_BLOCK
    start = jnp.cumsum(counts) - counts
    pad_end = jnp.cumsum(padded)
    pad_start = pad_end - padded
    dest = pad_start[sorted_e] + jnp.arange(n_assign) - start[sorted_e]
    n_blocks = -(-(n_assign + N_EXPERTS * (MOE_BLOCK - 1)) // MOE_BLOCK)
    n_rows = n_blocks * MOE_BLOCK
    src_token = order // TOP_K
    row_token = jnp.full((n_rows,), t, jnp.int32).at[dest].set(src_token)
    u_pad = jnp.concatenate([u, jnp.zeros((1, d), u.dtype)], axis=0)
    x_rows = u_pad[row_token].reshape(n_blocks, MOE_BLOCK, d)
    block_e = jnp.minimum(jnp.searchsorted(pad_end, jnp.arange(n_blocks) * MOE_BLOCK, side='right'),
                          N_EXPERTS - 1)

    def expert_block(args):
        xb, e = args
        g = jnp.minimum(xb @ w_gate[e] + b_gate[e], SWIGLU_LIMIT)
        lin = jnp.clip(xb @ w_up[e] + b_up[e], -SWIGLU_LIMIT, SWIGLU_LIMIT)
        h = g * jax.nn.sigmoid(SWIGLU_ALPHA * g) * (lin + 1)
        return h @ w_down[e] + b_down[e]

    y_rows = lax.map(expert_block, (x_rows, block_e)).reshape(n_rows, d)
    y_assign = y_rows[dest] * top_w.reshape(n_assign)[order][:, None].astype(y_rows.dtype)
    return jnp.zeros((t, d), y_rows.dtype).at[src_token].add(y_assign)


def setup_inputs(seed: int = 0) -> dict:
    key = jax.random.key(seed)
    ks = jax.random.split(key, 28)
    f32 = jnp.float32
    L, D, E, F = DEPTH, D_MODEL, N_EXPERTS, D_FF

    def nrm(k, shape, scale):
        return jax.random.normal(k, shape, f32) * scale

    return {
        'x': nrm(ks[0], (BATCH, SEQ, D), 1.0),
        'c': nrm(ks[1], (BATCH, D), 1.0),
        'ctx': nrm(ks[2], (BATCH, CTX_LEN, D), 1.0),
        'c_ctx': nrm(ks[3], (D,), 1.0),
        'w_ada': nrm(ks[4], (L, D, 6 * D), D ** -0.5),
        'b_ada': nrm(ks[5], (L, 6 * D), 0.02),
        'w_in': nrm(ks[6], (L, D, IN_COLS), D ** -0.5),
        'na_rel_bias': nrm(ks[7], (L, NA_HEADS, 2 * NA_WIN_H - 1, 2 * NA_WIN_W - 1), 0.2),
        'lam_q1': nrm(ks[8], (L, DIFF_HEAD_DIM), 0.1),
        'lam_k1': nrm(ks[9], (L, DIFF_HEAD_DIM), 0.1),
        'lam_q2': nrm(ks[10], (L, DIFF_HEAD_DIM), 0.1),
        'lam_k2': nrm(ks[11], (L, DIFF_HEAD_DIM), 0.1),
        'diff_subln_w': 1.0 + nrm(ks[12], (L, DIFF_V_DIM), 0.02),
        'w_proj_na': nrm(ks[13], (L, NA_WIDTH, D), NA_WIDTH ** -0.5),
        'w_proj_diff': nrm(ks[14], (L, DIFF_V_WIDTH, D), DIFF_V_WIDTH ** -0.5),
        'w_out': nrm(ks[15], (L, D, D), D ** -0.5 * DEEPNORM_BETA),
        'ln1_w': 1.0 + nrm(ks[16], (L, D), 0.02),
        'ln1_b': nrm(ks[17], (L, D), 0.02),
        'w_router': nrm(ks[18], (L, D, E), D ** -0.5),
        'b_router': nrm(ks[19], (L, E), 0.01),
        'w_gate': nrm(ks[20], (L, E, D, F), D ** -0.5),
        'b_gate': nrm(ks[21], (L, E, F), 0.02),
        'w_up': nrm(ks[22], (L, E, D, F), D ** -0.5),
        'b_up': nrm(ks[23], (L, E, F), 0.02),
        'w_down': nrm(ks[24], (L, E, F, D), F ** -0.5 * DEEPNORM_BETA),
        'b_down': nrm(ks[25], (L, E, D), 0.02),
        'ln2_w': 1.0 + nrm(ks[26], (L, D), 0.02),
        'ln2_b': nrm(ks[27], (L, D), 0.02),
    }


def reference(x, c, ctx, c_ctx, w_ada, b_ada, w_in, na_rel_bias, lam_q1, lam_k1, lam_q2, lam_k2,
              diff_subln_w, w_proj_na, w_proj_diff, w_out, ln1_w, ln1_b, w_router, b_router,
              w_gate, b_gate, w_up, b_up, w_down, b_down, ln2_w, ln2_b):
    b, s, d = x.shape
    tok = jnp.arange(s)
    row_pos = (tok // GRID_W).astype(jnp.float32)
    col_pos = (tok % GRID_W).astype(jnp.float32)
    for l in range(DEPTH):
        last = l == DEPTH - 1
        lam_init = 0.8 - 0.6 * math.exp(-0.3 * l)
        mod = jax.nn.silu(c) @ w_ada[l] + b_ada[l]
        mod_c = jax.nn.silu(c_ctx) @ w_ada[l] + b_ada[l]
        sh_m, sc_m, g_m, sh_f, sc_f, g_f = [m[:, None, :] for m in jnp.split(mod, 6, axis=-1)]
        sh_mc, sc_mc, g_mc, sh_fc, sc_fc, g_fc = jnp.split(mod_c, 6, axis=-1)
        lam = _diff_lambda(lam_q1[l], lam_k1[l], lam_q2[l], lam_k2[l], lam_init)

        u = _modulate(x, sh_m, sc_m)
        uc = _modulate(ctx, sh_mc, sc_mc)
        y, yc = _token_mixer(u, uc, w_in[l], na_rel_bias[l], lam, lam_init, diff_subln_w[l],
                             w_proj_na[l], w_proj_diff[l], w_out[l], row_pos, col_pos, not last)
        x = _layernorm(DEEPNORM_ALPHA * x + g_m * y, ln1_w[l], ln1_b[l])

        u2 = _modulate(x, sh_f, sc_f)
        y2 = _moe_ffn(u2.reshape(b * s, d), w_router[l], b_router[l], w_gate[l], b_gate[l],
                      w_up[l], b_up[l], w_down[l], b_down[l]).reshape(b, s, d)
        x = _layernorm(DEEPNORM_ALPHA * x + g_f * y2, ln2_w[l], ln2_b[l])

        if not last:
            ctx = _layernorm(DEEPNORM_ALPHA * ctx + g_mc * yc, ln1_w[l], ln1_b[l])
            uc2 = _modulate(ctx, sh_fc, sc_fc)
            yc2 = _moe_ffn(uc2.reshape(-1, d), w_router[l], b_router[l], w_gate[l], b_gate[l],
                           w_up[l], b_up[l], w_down[l], b_down[l]).reshape(ctx.shape)
            ctx = _layernorm(DEEPNORM_ALPHA * ctx + g_fc * yc2, ln2_w[l], ln2_b[l])
    return x
```

```cpp
#include <hip/hip_runtime.h>
#include <hip/hip_bf16.h>
#include <cstdio>
#include <cstdint>

#ifndef MK_SPLIT
#define MK_SPLIT 0
#endif

#define GAS __attribute__((address_space(1)))
#define LAS __attribute__((address_space(3)))
typedef unsigned short bf16_t;
typedef short bf16x8 __attribute__((ext_vector_type(8)));
typedef short s16x4 __attribute__((ext_vector_type(4)));
typedef float f32x2 __attribute__((ext_vector_type(2)));
typedef float f32x4 __attribute__((ext_vector_type(4)));
typedef float f32x16 __attribute__((ext_vector_type(16)));
typedef unsigned u32x2 __attribute__((ext_vector_type(2)));
typedef unsigned u32x4 __attribute__((ext_vector_type(4)));
typedef int i32x4 __attribute__((ext_vector_type(4)));
typedef int i32x8 __attribute__((ext_vector_type(8)));
typedef GAS unsigned gu32;
#define RLX_AGENT __ATOMIC_RELAXED, __HIP_MEMORY_SCOPE_AGENT
#define LDS_WAIT() asm volatile("s_waitcnt lgkmcnt(0)" ::: "memory")
#define VM_WAIT() asm volatile("s_waitcnt vmcnt(0)" ::: "memory")

constexpr int DM = 2048, SEQ = 4096, NBATCH = 2, CTXL = 256, RPB = SEQ + CTXL  , MTOT = NBATCH * RPB  , NTOK = NBATCH * SEQ  ;
constexpr int INC = 10240;
constexpr int NH = 8, HD = 128, GRIDW = 64;
constexpr int NEXP = 32, TOPK = 4, DFF = 2048;
constexpr int MAXTILES = 160;
constexpr float LN_EPS = 1e-6f, RMS_EPS = 1e-5f;
constexpr float DN_ALPHA = 1.189207115002721f;
constexpr float LAM_INIT = 0.2f;
constexpr float PSCALE = 8.0f, PSCALE_INV = 1.0f / 8.0f;
constexpr float WSCALE = 64.0f, WSCALE_INV = 1.0f / 64.0f;

constexpr size_t MiB = 1u << 20;
constexpr size_t WS_CTL = 0, CTL_ZERO_BYTES = 1 * MiB;
constexpr size_t WS_MOD = 1 * MiB;
constexpr size_t WS_ROPE = WS_MOD + 256 * 1024;
constexpr size_t WS_ASG_E = 2 * MiB, WS_ASG_P = WS_ASG_E + 128 * 1024, WS_ASG_W = WS_ASG_P + 128 * 1024;
constexpr size_t WS_TOKL = 3 * MiB;
constexpr size_t WS_WINT = 4 * MiB;
constexpr size_t WS_WPNAT = 44 * MiB, WS_WPDFT = 48 * MiB;
constexpr size_t WS_WOT = 52 * MiB;
constexpr size_t WS_WRT = 60 * MiB;
constexpr size_t WS_WGUT = 64 * MiB;
constexpr size_t WS_WDT = 576 * MiB;
constexpr size_t WS_U = 832 * MiB;
constexpr size_t WS_KV = 866 * MiB;
constexpr size_t KV_STRIDE = (size_t)MTOT * 1024 * 2;
constexpr size_t WS_QNA = 934 * MiB, WS_QDF = 950 * MiB;
constexpr size_t WS_GNA = 966 * MiB, WS_GDF = 998 * MiB;
constexpr size_t WS_ONA = 1030 * MiB, WS_ODF = 1046 * MiB;
constexpr size_t WS_O1S = 1062 * MiB;
constexpr size_t WS_T = 1094 * MiB;
constexpr size_t WS_YPRE = 1158 * MiB;
constexpr size_t WS_Z = 1190 * MiB;
constexpr size_t WS_X1 = 1254 * MiB;
constexpr size_t WS_U2H = 1318 * MiB, WS_U2L = 1350 * MiB;
constexpr size_t WS_U2F = 704 * MiB;
constexpr size_t WS_WG8 = 720 * MiB;
constexpr size_t WS_UF8 = 736 * MiB;
constexpr size_t WS_WO8 = 728 * MiB;
constexpr size_t WS_YP8 = 754 * MiB;
constexpr size_t WS_H = 832 * MiB;
constexpr size_t WS_Y = 1094 * MiB;
constexpr size_t WS_END = 1382 * MiB;
static_assert(WS_H + (size_t)MAXTILES * 256 * 2048 * 2 <= WS_ONA, "H overlay");
static_assert(WS_Y + (size_t)MAXTILES * 256 * 2048 * 2 <= WS_X1, "Y overlay");
constexpr int CW_BAR = 4096;
constexpr int CW_CNT = 16384;

constexpr int RING_BYTES = 131072;
constexpr int TAB_OFF = RING_BYTES, TAB_BYTES = 20480;
constexpr int MISC_OFF = TAB_OFF + TAB_BYTES;
constexpr int LDS_BYTES = MISC_OFF + 256;
static_assert(LDS_BYTES <= 160 * 1024, "LDS");

#define XB_TMO      128
#define XB_XCNT(j)  (256  + 64 * (j))
#define XB_XSUB(j)  (1280 + 64 * (j))
#define XB_XGEN(j)  (2304 + 64 * (j))
#define XB_TOP      3328
#define XB_TOPGEN   3392
#define XCD_BAR_WORDS 3456
#define XB_SPIN_CAP (1u << 18)
__device__ __forceinline__ unsigned xb_ld(unsigned* p)              { return __hip_atomic_load(p, __ATOMIC_RELAXED, __HIP_MEMORY_SCOPE_AGENT); }
__device__ __forceinline__ unsigned xb_add(unsigned* p, unsigned v) { return __hip_atomic_fetch_add(p, v, __ATOMIC_RELAXED, __HIP_MEMORY_SCOPE_AGENT); }
__device__ __forceinline__ unsigned xb_xcc_id() { return (unsigned)__builtin_amdgcn_s_getreg((3 << 11) | 20) & 0xFu; }
#define XB_SPIN(cond, bar) do { unsigned _sp = 0; while (cond) { __builtin_amdgcn_s_sleep(1); \
    if ((++_sp & 255u) == 0u) { if (xb_ld(&(bar)[XB_TMO])) break; if (_sp > XB_SPIN_CAP) { atomicAdd(&(bar)[XB_TMO], 1u); break; } } } } while (0)
struct XcdBarrier { unsigned* bar; unsigned x; volatile LAS unsigned* st; };
__device__ __forceinline__ XcdBarrier xcd_barrier_post(unsigned* bar, volatile LAS unsigned* st) {
    XcdBarrier b; b.bar = bar; b.x = xb_xcc_id(); b.st = st;
    if (threadIdx.x == 0) (void)xb_add(&bar[XB_XCNT(b.x)], 1u);
    return b;
}
__device__ __forceinline__ void xcd_barrier_complete(unsigned* bar, unsigned x, unsigned& nloc, unsigned& nx) {
    const unsigned G = gridDim.x * gridDim.y * gridDim.z;
    unsigned sum, cnt, mine, sp = 0u;
    for (;;) {
        sum = 0u; cnt = 0u; mine = 0u;
#pragma unroll
        for (unsigned j = 0; j < 16; ++j) { const unsigned c = xb_ld(&bar[XB_XCNT(j)]); sum += c; cnt += (c > 0u) ? 1u : 0u; mine = (j == x) ? c : mine; }
        if (sum == G) break;
        __builtin_amdgcn_s_sleep(1);
        if ((++sp & 255u) == 0u) { if (xb_ld(&bar[XB_TMO])) break; if (sp > XB_SPIN_CAP) { atomicAdd(&bar[XB_TMO], 1u); break; } }
    }
    nloc = mine > 0u ? mine : 1u; nx = cnt > 0u ? cnt : 1u;
}
__device__ __forceinline__ void xcd_barrier(const XcdBarrier& b) {
    asm volatile("s_waitcnt vmcnt(0)" ::: "memory");
    __syncthreads();
    if (threadIdx.x == 0) {
        unsigned* bar = b.bar;
        __builtin_amdgcn_s_waitcnt(0);
        unsigned nloc = b.st[0], nx = b.st[1];
        if (nloc == 0u) { xcd_barrier_complete(bar, b.x, nloc, nx); b.st[0] = nloc; b.st[1] = nx; }
        const unsigned old = xb_add(&bar[XB_XSUB(b.x)], 1u);
        const unsigned gen = old / nloc;
        if (old + 1u == (gen + 1u) * nloc) {
            __builtin_amdgcn_fence(__ATOMIC_RELEASE, "agent");
            asm volatile("s_waitcnt vmcnt(0)" ::: "memory");
            const unsigned og = xb_add(&bar[XB_TOP], 1u);
            const unsigned tg = og / nx;
            if (og + 1u == (tg + 1u) * nx) xb_add(&bar[XB_TOPGEN], 1u);
            else XB_SPIN(xb_ld(&bar[XB_TOPGEN]) == tg, bar);
            __builtin_amdgcn_fence(__ATOMIC_ACQUIRE, "agent");
            xb_add(&bar[XB_XGEN(b.x)], 1u);
            asm volatile("s_waitcnt vmcnt(0)" ::: "memory");
        } else {
            XB_SPIN(xb_ld(&bar[XB_XGEN(b.x)]) == gen, bar);
            __builtin_amdgcn_fence(__ATOMIC_ACQUIRE, "agent");
            asm volatile("s_waitcnt vmcnt(0)" ::: "memory");
        }
    }
    __syncthreads();
}

__device__ __forceinline__ unsigned cvt_pk_bf16(float lo, float hi) { unsigned r; asm volatile("v_cvt_pk_bf16_f32 %0, %1, %2" : "=v"(r) : "v"(lo), "v"(hi)); return r; }
__device__ __forceinline__ unsigned pk4_fp8(float a, float b, float c, float d) { int w = 0; w = __builtin_amdgcn_cvt_pk_fp8_f32(a, b, w, false); w = __builtin_amdgcn_cvt_pk_fp8_f32(c, d, w, true); return (unsigned)w; }
__device__ __forceinline__ float bf_lo(unsigned w) { return __uint_as_float(w << 16); }
__device__ __forceinline__ float bf_hi(unsigned w) { return __uint_as_float(w & 0xffff0000u); }
__device__ __forceinline__ float wave_sum(float v) {
#pragma unroll
    for (int o = 1; o < 64; o <<= 1) v += __shfl_xor(v, o);
    return v;
}
__device__ __forceinline__ float sigmoidf_fast(float x) { return __builtin_amdgcn_rcpf(1.0f + __builtin_amdgcn_exp2f(-1.4426950408889634f * x)); }

namespace pg8 {
constexpr int BM = 256, BK = 64, HALF = 128, HTB = HALF * BK * 2, STAGE_BYTES = 8 * HTB;
__host__ __device__ __forceinline__ int lds_byte(int r, int c) { const int st = (r >> 4) * 2 + (c >> 5), rr = r & 15, cc = c & 31, ob = rr * 64 + cc * 2; return st * 1024 + (ob ^ (((ob >> 9) & 1) << 5)); }
__host__ __device__ __forceinline__ void stage_rc(int b, int& R, int& C) { const int st = b / 1024, sb = b % 1024, swz = sb ^ (((sb >> 9) & 1) << 5); R = (st >> 1) * 16 + swz / 64; C = (st & 1) * 32 + (swz % 64) / 2; }
__host__ __device__ __forceinline__ int perm32(int rho) { const int n = rho >> 4, i = rho & 15; return 8 * (i >> 2) + 4 * n + (i & 3); }

struct Unit { const char* A; const char* B; int row0, col0, tag, aux; };

template <class E, class = void> struct EpiWide { static constexpr bool value = false; };
template <class E> struct EpiWide<E, decltype((void)E::WIDE)> { static constexpr bool value = E::WIDE; };
template <class E> constexpr bool epi_wide() { return EpiWide<E>::value; }
template <class E, class = void> struct EpiKeep { static __device__ __forceinline__ bool get(const Unit&) { return false; } };
template <class E> struct EpiKeep<E, decltype((void)E::KEEPS)> { static __device__ __forceinline__ bool get(const Unit& u) { return E::keep(u); } };
template <class E> __device__ __forceinline__ bool epi_keep(const Unit& u) { return EpiKeep<E>::get(u); }
template <class Epi, class Sched, bool GATHER, bool F8 = false>
__device__ __forceinline__ void gemm_phase(LAS unsigned char* lds, const int K, const Sched& S, const Epi& E) {
    const int tid = threadIdx.x, wid = __builtin_amdgcn_readfirstlane(tid >> 6), lane = tid & 63, wr = wid >> 2, wc = wid & 3, fr = lane & 15, fq = lane >> 4;
    const int nt = K / BK;
    int RA[2], CA[2];
    unsigned voffB[2], vA[2][2], vN[2][2];
    const size_t kstep = (size_t)(BK * 2);
    const size_t hstep = (size_t)HALF * K * 2;
    const size_t hstepB = epi_wide<Epi>() ? (size_t)32 * K * 2 : hstep;
#pragma unroll
    for (int i = 0; i < 2; ++i) { int R, C; stage_rc(tid * 16 + i * 8192, R, C); const int Rb = epi_wide<Epi>() ? (64 * (R >> 5) + perm32(R & 31)) : (Epi::PERM ? ((R & ~31) + perm32(R & 31)) : R);
        RA[i] = R; CA[i] = C; voffB[i] = (unsigned)(Rb * K + C) * 2u;
        vA[0][i] = (unsigned)(R * K + C) * 2u; vA[1][i] = vA[0][i] + (unsigned)hstep; }
    const unsigned ldsw = (unsigned)wid * 1024u;
    const int aoff = lds_byte(wr * 64 + fr, fq * 8), boff = lds_byte(wc * 32 + fr, fq * 8);
#define PG8_SA(b, h) (((b) * 2 + (h)) * HTB)
#define PG8_SB(b, h) ((4 + (b) * 2 + (h)) * HTB)
#define PG8_STAGE(bufoff, gbase, voff) do { _Pragma("unroll") for (int _i = 0; _i < 2; ++_i) \
        __builtin_amdgcn_global_load_lds((const unsigned*)((const char*)(gbase) + (voff)[_i]), (LAS unsigned*)(lds + (bufoff) + ldsw + _i * 8192), 16, 0, 0); } while (0)
#define PG8_LD32(p) __builtin_shufflevector(*(const LAS i32x4*)(p), *(const LAS i32x4*)((p) + 1024), 0, 1, 2, 3, 4, 5, 6, 7)
#define PG8_LDA(dst, b, h) do { _Pragma("unroll") for (int m = 0; m < 4; ++m) { if constexpr (F8) dst##8[m] = PG8_LD32(lds + PG8_SA(b, h) + aoff + m * 2048); \
        else { _Pragma("unroll") for (int k = 0; k < 2; ++k) dst[m][k] = *(const LAS bf16x8*)(lds + PG8_SA(b, h) + aoff + m * 2048 + k * 1024); } } } while (0)
#define PG8_LDB(dst, b, h) do { _Pragma("unroll") for (int n = 0; n < 2; ++n) { if constexpr (F8) dst##8[n] = PG8_LD32(lds + PG8_SB(b, h) + boff + n * 2048); \
        else { _Pragma("unroll") for (int k = 0; k < 2; ++k) dst[n][k] = *(const LAS bf16x8*)(lds + PG8_SB(b, h) + boff + n * 2048 + k * 1024); } } } while (0)
#define PG8_MMA(ai, bj, At, Bt) do { __builtin_amdgcn_s_setprio(1); _Pragma("unroll") for (int m = 0; m < 4; ++m) _Pragma("unroll") for (int n = 0; n < 2; ++n) { \
        if constexpr (F8) asm volatile("v_mfma_scale_f32_16x16x128_f8f6f4 %0, %1, %2, %0, %3, %3 op_sel_hi:[0,0,0]" : "+v"(acc[ai][bj][m][n]) : "v"(Bt##8[n]), "v"(At##8[m]), "v"(one_scale)); \
        else { _Pragma("unroll") for (int k = 0; k < 2; ++k) acc[ai][bj][m][n] = __builtin_amdgcn_mfma_f32_16x16x32_bf16(Bt[n][k], At[m][k], acc[ai][bj][m][n], 0, 0, 0); } } \
        __builtin_amdgcn_s_setprio(0); } while (0)
#define PG8_WAIT_V(n) asm volatile("s_waitcnt vmcnt(" #n ")" ::: "memory")
#define PG8_WAIT_L(n) asm volatile("s_waitcnt lgkmcnt(" #n ")" ::: "memory")
#define PG8_BAR __builtin_amdgcn_s_barrier()
#define PG8_SCHED __builtin_amdgcn_sched_barrier(0)
    Unit cur, nxt; int ui = 0;
    if (!S.next(0, cur)) return;
    if constexpr (GATHER) { S.offsets(0, RA, CA, vA); }
#pragma unroll
    for (int h = 0; h < 2; ++h)
#pragma unroll
        for (int i = 0; i < 2; ++i) vN[h][i] = vA[h][i];
    f32x4 acc[2][2][4][2];
#pragma unroll
    for (int a = 0; a < 2; ++a)
#pragma unroll
        for (int b = 0; b < 2; ++b)
#pragma unroll
            for (int m = 0; m < 4; ++m)
#pragma unroll
                for (int n = 0; n < 2; ++n) acc[a][b][m][n] = (f32x4){0.f, 0.f, 0.f, 0.f};
    int one_scale = 0x7f7f7f7f; asm volatile("" : "+v"(one_scale));
    bf16x8 At[4][2], B0[2][2], B1[2][2]; i32x8 At8[4], B08[2], B18[2];
    const char* cA = cur.A; const char* cB = cur.B;
    PG8_STAGE(PG8_SB(0, 0), cB, voffB); PG8_STAGE(PG8_SB(0, 1), cB + hstepB, voffB); PG8_STAGE(PG8_SA(0, 0), cA, vA[0]); PG8_STAGE(PG8_SA(0, 1), cA, vA[1]);
    if (wr == 1) PG8_BAR;
    PG8_WAIT_V(2); PG8_BAR;
    PG8_STAGE(PG8_SB(1, 0), cB + kstep, voffB); PG8_STAGE(PG8_SA(1, 0), cA + kstep, vA[0]); PG8_STAGE(PG8_SB(1, 1), cB + hstepB + kstep, voffB);
    PG8_WAIT_V(6); PG8_BAR;
    for (;;) {
        const bool has_next = S.next(ui + 1, nxt);
        const char* nA = has_next ? nxt.A : cA; const char* nB = has_next ? nxt.B : cB;
        for (int t = 0; t < nt; t += 2) {
            const bool last = (t == nt - 2);
            const char* a1 = cA + (size_t)(t + 1) * kstep;
            const char* a2 = last ? nA : cA + (size_t)(t + 2) * kstep; const char* b2 = last ? nB : cB + (size_t)(t + 2) * kstep;
            const char* a3 = a2 + kstep; const char* b3 = b2 + kstep;
            if constexpr (GATHER) { if (last && has_next) S.offsets(ui + 1, RA, CA, vN); }
            PG8_LDB(B0, 0, 0); PG8_LDB(B1, 0, 1); PG8_SCHED; PG8_LDA(At, 0, 0); PG8_STAGE(PG8_SA(1, 1), a1, vA[1]);
            PG8_WAIT_V(8); PG8_WAIT_L(0); PG8_BAR; PG8_MMA(0, 0, At, B0); PG8_MMA(0, 1, At, B1); PG8_BAR; PG8_SCHED;
            PG8_LDA(At, 0, 1); PG8_STAGE(PG8_SB(0, 0), b2, voffB); PG8_STAGE(PG8_SB(0, 1), b2 + hstepB, voffB); PG8_STAGE(PG8_SA(0, 0), a2, vN[0]);
            PG8_WAIT_V(8); PG8_WAIT_L(0); PG8_BAR; PG8_MMA(1, 0, At, B0); PG8_MMA(1, 1, At, B1); PG8_BAR; PG8_SCHED;
            PG8_LDB(B0, 1, 0); PG8_LDB(B1, 1, 1); PG8_SCHED; PG8_LDA(At, 1, 0); PG8_STAGE(PG8_SA(0, 1), a2, vN[1]);
            PG8_WAIT_V(8); PG8_WAIT_L(0); PG8_BAR; PG8_MMA(0, 0, At, B0); PG8_MMA(0, 1, At, B1); PG8_BAR; PG8_SCHED;
            PG8_LDA(At, 1, 1); PG8_STAGE(PG8_SB(1, 0), b3, voffB); PG8_STAGE(PG8_SB(1, 1), b3 + hstepB, voffB); PG8_STAGE(PG8_SA(1, 0), a3, vN[0]);
            PG8_WAIT_V(8); PG8_WAIT_L(0); PG8_BAR; PG8_MMA(1, 0, At, B0); PG8_MMA(1, 1, At, B1); PG8_BAR; PG8_SCHED;
        }
        if (wr == 0) PG8_BAR;
        if constexpr (F8) { asm volatile("s_nop 15\n\ts_nop 15" ::: "memory"); PG8_SCHED; }
        E(acc, cur, wr, wc, fr, fq);
        if (!has_next) break;
        if (!epi_keep<Epi>(cur))
#pragma unroll
        for (int a = 0; a < 2; ++a)
#pragma unroll
            for (int b = 0; b < 2; ++b)
#pragma unroll
                for (int m = 0; m < 4; ++m)
#pragma unroll
                    for (int n = 0; n < 2; ++n) acc[a][b][m][n] = (f32x4){0.f, 0.f, 0.f, 0.f};
        cur = nxt; cA = nA; cB = nB; ++ui;
        if constexpr (GATHER) {
#pragma unroll
            for (int h = 0; h < 2; ++h)
#pragma unroll
                for (int i = 0; i < 2; ++i) vA[h][i] = vN[h][i];
        }
        if (wr == 1) PG8_BAR;
    }
    PG8_WAIT_V(0);
    PG8_BAR;
#undef PG8_SA
#undef PG8_SB
#undef PG8_STAGE
#undef PG8_LDA
#undef PG8_LDB
#undef PG8_MMA
#undef PG8_LD32
#undef PG8_WAIT_V
#undef PG8_WAIT_L
#undef PG8_BAR
#undef PG8_SCHED
}
}

struct Frame {
    LAS unsigned char* lds;
    volatile LAS unsigned* MISC;
    gu32* ctl;
    unsigned char* ws;
    int tid, lane, wave, vcu, G;
    const float* in[28];
    float* out;
};
enum { I_X = 0, I_C, I_CTX, I_CCTX, I_WADA, I_BADA, I_WIN, I_RELB, I_LQ1, I_LK1, I_LQ2, I_LK2, I_SUBLN, I_WPNA, I_WPDF, I_WOUT, I_LN1W, I_LN1B,
       I_WR, I_BR, I_WG, I_BG, I_WU, I_BU, I_WD, I_BD, I_LN2W, I_LN2B };

using pg8::Unit;

struct InprojOrder {
    int c, G; const char* U; const char* W;
    __device__ __forceinline__ bool next(int i, Unit& u) const {
        const int L = i * G + c; if (L >= 800) return false;
        int pmr, pn, lt;
        if (L < 768) {
            const int w = (L % 8) * 96 + L / 8, nig = 8 * 24, gid = w / nig, fm = gid * 8;
            lt = fm + ((w % nig) % 8); pn = (w % nig) / 8; pmr = lt + (lt >= 16 ? 1 : 0);
        } else { const int q = L - 768; pmr = (q & 1) ? 33 : 16; pn = q >> 1; lt = -1; }
        u.A = U + (size_t)pmr * 256 * DM * 2; u.B = W + (size_t)pn * 256 * DM * 2; u.row0 = pmr * 256; u.col0 = pn * 256; u.tag = lt; u.aux = 0;
        return true;
    }
};
struct GateOrder {
    int c, G; const char* UF; const char* W;
    __device__ __forceinline__ bool next(int i, Unit& u) const {
        if (c < 32) return false;
        const int L = i * (G - 32) + (c - 32); if (L >= 512) return false;
        const int lt = L >> 4, pn = L & 15, pmr = lt + (lt >= 16 ? 1 : 0);
        u.A = UF + (size_t)pmr * 256 * DM; u.B = W + (size_t)pn * 256 * DM; u.row0 = lt * 256; u.col0 = pn * 256; u.tag = lt; u.aux = 0; return true;
    }
};
struct EpiGate {
    static constexpr bool PERM = true, WIDE = true;
    bf16_t* GNA; bf16_t* GDF; LAS unsigned char* scr;
    __device__ __forceinline__ void operator()(const f32x4 (&acc)[2][2][4][2], const Unit& u, int wr, int wc, int fr, int fq) const {
        const int lane = threadIdx.x & 63, pn = u.col0 >> 8; LAS unsigned char* my = scr + (threadIdx.x >> 6) * 2304;
        bf16_t* base = (pn < 8 ? GNA : GDF) + (pn & 7) * 256 + wc * 64 + 8 * (lane & 7);
#pragma unroll
        for (int ai = 0; ai < 2; ++ai)
#pragma unroll
            for (int m = 0; m < 4; ++m) {
#pragma unroll
                for (int bj = 0; bj < 2; ++bj) { const f32x4 v0 = acc[ai][bj][m][0] * WSCALE_INV, v1 = acc[ai][bj][m][1] * WSCALE_INV;
                    u32x4 w; w.x = cvt_pk_bf16(v0[0], v0[1]); w.y = cvt_pk_bf16(v0[2], v0[3]); w.z = cvt_pk_bf16(v1[0], v1[1]); w.w = cvt_pk_bf16(v1[2], v1[3]);
                    *(LAS u32x4*)(my + fr * 144 + bj * 64 + fq * 16) = w; }
#pragma unroll
                for (int hh = 0; hh < 2; ++hh) { const int row = (lane >> 3) + 8 * hh; const u32x4 x = *(const LAS u32x4*)(my + row * 144 + (lane & 7) * 16);
                    *(u32x4*)(base + (size_t)(u.row0 + ai * 128 + wr * 64 + m * 16 + row) * DM) = x; }
            }
    }
};
struct EpiInproj {
    static constexpr bool PERM = true;
    unsigned char* ws; const f32x2* rope; int nostore;
    __device__ __forceinline__ void operator()(const f32x4 (&acc)[2][2][4][2], const Unit& u, int wr, int wc, int fr, int fq) const {
        const int pn = u.col0 >> 8, t = pn >> 2, lt = u.tag;
        bf16_t* base; int ldc, colt, rowb;
        if (t < 4) { base = (bf16_t*)(ws + WS_KV + (size_t)t * KV_STRIDE); ldc = 1024; colt = (pn & 3) * 256; rowb = u.row0; }
        else if (t == 4) { base = (bf16_t*)(ws + WS_QNA); ldc = 1024; colt = (pn & 3) * 256; rowb = lt * 256; }
        else if (t == 5) { base = (bf16_t*)(ws + WS_QDF); ldc = 1024; colt = (pn & 3) * 256; rowb = lt * 256; }
        else if (t < 8) { base = (bf16_t*)(ws + WS_GNA); ldc = 2048; colt = (pn - 24) * 256; rowb = lt * 256; }
        else { base = (bf16_t*)(ws + WS_GDF); ldc = 2048; colt = (pn - 32) * 256; rowb = lt * 256; }
        const bool do_rope = (lt >= 0) && (t == 2 || t == 5);
        const int col0 = colt + wc * 32 + 8 * fq;
#pragma unroll
        for (int ai = 0; ai < 2; ++ai)
#pragma unroll
            for (int m = 0; m < 4; ++m) {
                const int rl = ai * 128 + wr * 64 + m * 16 + fr;
                bf16_t* rowp = base + (size_t)(rowb + rl) * ldc + col0;
                const int s = (lt * 256 + rl) & 4095, rpos = s >> 6, cpos = s & 63;
#pragma unroll
                for (int bj = 0; bj < 2; ++bj) {
                    f32x4 v0 = acc[ai][bj][m][0], v1 = acc[ai][bj][m][1];
                    if (do_rope) {
                        const int pos = ((bj * 4 + wc) & 1) ? cpos : rpos;
                        const f32x4* cs = (const f32x4*)(rope + pos * 16 + 4 * fq);
                        const f32x4 c01 = cs[0], c23 = cs[1];
                        const float cc[4] = {c01[0], c01[2], c23[0], c23[2]}, sn[4] = {c01[1], c01[3], c23[1], c23[3]};
                        f32x4 o0, o1;
#pragma unroll
                        for (int e = 0; e < 4; ++e) { o0[e] = v0[e] * cc[e] - v1[e] * sn[e]; o1[e] = v1[e] * cc[e] + v0[e] * sn[e]; }
                        v0 = o0; v1 = o1;
                    }
                    u32x4 w; w.x = cvt_pk_bf16(v0[0], v0[1]); w.y = cvt_pk_bf16(v0[2], v0[3]); w.z = cvt_pk_bf16(v1[0], v1[1]); w.w = cvt_pk_bf16(v1[2], v1[3]);
                    if (!nostore || w.x == 0x12345678u) *(u32x4*)(rowp + bj * 128) = w;
                }
            }
    }
};

struct EpiInprojW {
    static constexpr bool PERM = true, WIDE = true;
    unsigned char* ws; const f32x2* rope; LAS unsigned char* scr;
    __device__ __forceinline__ void operator()(const f32x4 (&acc)[2][2][4][2], const Unit& u, int wr, int wc, int fr, int fq) const {
        const int pn = u.col0 >> 8, t = pn >> 2, lt = u.tag, lane = threadIdx.x & 63;
        LAS unsigned char* my = scr + (threadIdx.x >> 6) * 2304;
        bf16_t* base; int ldc, colt, rowb;
        if (t < 4) { base = (bf16_t*)(ws + WS_KV + (size_t)t * KV_STRIDE); ldc = 1024; colt = (pn & 3) * 256; rowb = u.row0; }
        else if (t == 4) { base = (bf16_t*)(ws + WS_QNA); ldc = 1024; colt = (pn & 3) * 256; rowb = lt * 256; }
        else if (t == 5) { base = (bf16_t*)(ws + WS_QDF); ldc = 1024; colt = (pn & 3) * 256; rowb = lt * 256; }
        else if (t < 8) { base = (bf16_t*)(ws + WS_GNA); ldc = 2048; colt = (pn - 24) * 256; rowb = lt * 256; }
        else { base = (bf16_t*)(ws + WS_GDF); ldc = 2048; colt = (pn - 32) * 256; rowb = lt * 256; }
        const bool do_rope = (lt >= 0) && (t == 2 || t == 5);
        const int colw = colt + wc * 64 + 8 * (lane & 7);
#pragma unroll
        for (int ai = 0; ai < 2; ++ai)
#pragma unroll
            for (int m = 0; m < 4; ++m) {
                const int rl = ai * 128 + wr * 64 + m * 16 + fr;
                const int s = (lt * 256 + rl) & 4095, rpos = s >> 6, cpos = s & 63;
#pragma unroll
                for (int bj = 0; bj < 2; ++bj) {
                    f32x4 v0 = acc[ai][bj][m][0], v1 = acc[ai][bj][m][1];
                    if (do_rope) {
                        const int pos = bj ? cpos : rpos;
                        const f32x4* cs = (const f32x4*)(rope + pos * 16 + 4 * fq);
                        const f32x4 c01 = cs[0], c23 = cs[1];
                        const float cc[4] = {c01[0], c01[2], c23[0], c23[2]}, sn[4] = {c01[1], c01[3], c23[1], c23[3]};
                        f32x4 o0, o1;
#pragma unroll
                        for (int e = 0; e < 4; ++e) { o0[e] = v0[e] * cc[e] - v1[e] * sn[e]; o1[e] = v1[e] * cc[e] + v0[e] * sn[e]; }
                        v0 = o0; v1 = o1;
                    }
                    u32x4 w; w.x = cvt_pk_bf16(v0[0], v0[1]); w.y = cvt_pk_bf16(v0[2], v0[3]); w.z = cvt_pk_bf16(v1[0], v1[1]); w.w = cvt_pk_bf16(v1[2], v1[3]);
                    *(LAS u32x4*)(my + fr * 144 + bj * 64 + fq * 16) = w;
                }
#pragma unroll
                for (int hh = 0; hh < 2; ++hh) { const int row = (lane >> 3) + 8 * hh; const u32x4 x = *(const LAS u32x4*)(my + row * 144 + (lane & 7) * 16);
                    *(u32x4*)(base + (size_t)(rowb + ai * 128 + wr * 64 + m * 16 + row) * ldc + colw) = x; }
            }
    }
};

__device__ __forceinline__ void static_tile(int L, int nM, int nN, int& pm, int& pn) {
    const int nwg = nM * nN, q = nwg / 8, r = nwg % 8, xcd = L % 8, off = L / 8;
    const int w = (xcd < r ? xcd * (q + 1) : r * (q + 1) + (xcd - r) * q) + off;
    const int nig = 8 * nN, gid = w / nig, fm = gid * 8, gsz = (nM - fm) < 8 ? (nM - fm) : 8;
    pm = fm + ((w % nig) % gsz); pn = (w % nig) / gsz;
}

struct MergeOrder {
    int c; const char* ONA; const char* ODF; const char* WNA; const char* WDF;
    __device__ __forceinline__ bool next(int i, Unit& u) const {
        if (i >= 2 || c >= 256) return false;
        int pm, pn; static_tile(c, 32, 8, pm, pn);
        u.A = (i == 0 ? ONA : ODF) + (size_t)pm * 256 * 1024 * 2; u.B = (i == 0 ? WNA : WDF) + (size_t)pn * 256 * 1024 * 2;
        u.row0 = pm * 256; u.col0 = pn * 256; u.tag = i; u.aux = 0; return true;
    }
};
struct EpiMerge {
    static constexpr bool PERM = true, WIDE = true, KEEPS = true;
    static __device__ __forceinline__ bool keep(const Unit& u) { return u.tag == 0; }
    const bf16_t* GNA; const bf16_t* GDF; unsigned char* YP8; LAS unsigned char* scr;
    __device__ __forceinline__ void operator()(f32x4 (&acc)[2][2][4][2], const Unit& u, int wr, int wc, int fr, int fq) const {
        const int lane = threadIdx.x & 63; LAS unsigned char* my = scr + (threadIdx.x >> 6) * 2304;
        const int col0 = u.col0 + wc * 64 + 8 * fq, colw = u.col0 + wc * 64 + 8 * (lane & 7);
#pragma unroll
        for (int ai = 0; ai < 2; ++ai)
#pragma unroll
            for (int m = 0; m < 4; ++m) {
                const size_t ro = (size_t)(u.row0 + ai * 128 + wr * 64 + m * 16 + fr) * DM + col0;
#pragma unroll
                for (int bj = 0; bj < 2; ++bj) {
                    const u32x4 gd = *(const u32x4*)(GDF + ro + bj * 32);
                    const float ed[8] = {bf_lo(gd.x), bf_hi(gd.x), bf_lo(gd.y), bf_hi(gd.y), bf_lo(gd.z), bf_hi(gd.z), bf_lo(gd.w), bf_hi(gd.w)};
                    if (u.tag == 0) {
                        const u32x4 gn = *(const u32x4*)(GNA + ro + bj * 32);
                        const float en[8] = {bf_lo(gn.x), bf_hi(gn.x), bf_lo(gn.y), bf_hi(gn.y), bf_lo(gn.z), bf_hi(gn.z), bf_lo(gn.w), bf_hi(gn.w)};
#pragma unroll
                        for (int e = 0; e < 8; ++e) {
                            const float r = (1.0f + __builtin_amdgcn_exp2f(-1.4426950408889634f * ed[e])) * __builtin_amdgcn_rcpf(1.0f + __builtin_amdgcn_exp2f(-1.4426950408889634f * en[e]));
                            acc[ai][bj][m][e >> 2][e & 3] *= r; }
                    } else {
                        float y[8];
#pragma unroll
                        for (int e = 0; e < 8; ++e) y[e] = acc[ai][bj][m][e >> 2][e & 3] * sigmoidf_fast(ed[e]) * PSCALE;
                        u32x2 w; w.x = pk4_fp8(y[0], y[1], y[2], y[3]); w.y = pk4_fp8(y[4], y[5], y[6], y[7]);
                        *(LAS u32x2*)(my + fr * 80 + bj * 32 + fq * 8) = w;
                    }
                }
                if (u.tag != 0) { const int row = lane >> 2; const u32x4 x = *(const LAS u32x4*)(my + row * 80 + (lane & 3) * 16);
                    *(u32x4*)(YP8 + (size_t)(u.row0 + ai * 128 + wr * 64 + m * 16 + row) * DM + u.col0 + wc * 64 + 16 * (lane & 3)) = x; }
            }
    }
};

struct OutOrder {
    int c; const char* A; const char* B;
    __device__ __forceinline__ bool next(int i, Unit& u) const {
        if (i >= 1 || c >= 256) return false;
        int pm, pn; static_tile(c, 32, 8, pm, pn);
        u.A = A + (size_t)pm * 256 * DM; u.B = B + (size_t)pn * 256 * DM; u.row0 = pm * 256; u.col0 = pn * 256; u.tag = 0; u.aux = 0; return true;
    }
};
struct EpiOut {
    static constexpr bool PERM = false;
    const float* x; const float* mod; float* Z;
    __device__ __forceinline__ void operator()(const f32x4 (&acc)[2][2][4][2], const Unit& u, int wr, int wc, int fr, int fq) const {
        const int col0 = u.col0 + wc * 32 + 4 * fq, b = u.row0 >> 12;
        const float* gm = mod + (size_t)b * 12288 + 4096 + col0;
        f32x4 gv[2][2];
#pragma unroll
        for (int bj = 0; bj < 2; ++bj)
#pragma unroll
            for (int n = 0; n < 2; ++n) gv[bj][n] = *(const f32x4*)(gm + bj * 128 + n * 16);
#pragma unroll
        for (int ai = 0; ai < 2; ++ai)
#pragma unroll
            for (int m = 0; m < 4; ++m) {
                const size_t ro = (size_t)(u.row0 + ai * 128 + wr * 64 + m * 16 + fr) * DM + col0;
#pragma unroll
                for (int bj = 0; bj < 2; ++bj)
#pragma unroll
                    for (int n = 0; n < 2; ++n) { const f32x4 xv = *(const f32x4*)(x + ro + bj * 128 + n * 16);
                        *(f32x4*)(Z + ro + bj * 128 + n * 16) = xv * DN_ALPHA + gv[bj][n] * (acc[ai][bj][m][n] * (WSCALE_INV * PSCALE_INV)); }
            }
    }
};

struct MoeTabs { const LAS int* tile_e; const LAS int* tile_r; const LAS int* tokl; int ntiles; };
struct Moe1Order {
    int c; MoeTabs tb; const char* U2; const char* W;
    __device__ __forceinline__ bool next(int i, Unit& u) const {
        const int x = c & 7, j = c >> 3, tile = 16 * i + 4 * (x >> 1) + (j & 3), nb = 8 * (x & 1) + (j >> 2);
        if (tile >= tb.ntiles) return false;
        const int e = tb.tile_e[tile];
        u.A = U2; u.B = W + ((size_t)(e * 16 + nb) * 256) * DM; u.row0 = tile * 256; u.col0 = nb * 128; u.tag = e; u.aux = i; return true;
    }
    __device__ __forceinline__ void offsets(int i, const int (&RA)[2], const int (&CA)[2], unsigned (&v)[2][2]) const {
#pragma unroll
        for (int h = 0; h < 2; ++h)
#pragma unroll
            for (int k = 0; k < 2; ++k) { const int tok = tb.tokl[i * 256 + RA[k] + 128 * h]; v[h][k] = (unsigned)(tok * (DM / 2) + CA[k]) * 2u; }
    }
};
struct EpiMoe1 {
    static constexpr bool PERM = true;
    const float* bg; const float* bu; unsigned char* H;
    __device__ __forceinline__ void operator()(const f32x4 (&acc)[2][2][4][2], const Unit& u, int wr, int wc, int fr, int fq) const {
        const int col0 = u.col0 + wc * 32 + 8 * fq;
        const float* pg = bg + (size_t)u.tag * DFF + col0; const float* pu = bu + (size_t)u.tag * DFF + col0;
        const f32x4 g0 = *(const f32x4*)pg, g1 = *(const f32x4*)(pg + 4), u0 = *(const f32x4*)pu, u1 = *(const f32x4*)(pu + 4);
#pragma unroll
        for (int ai = 0; ai < 2; ++ai)
#pragma unroll
            for (int m = 0; m < 4; ++m) {
                unsigned char* rowp = H + (size_t)(u.row0 + ai * 128 + wr * 64 + m * 16 + fr) * DFF + col0;
                float hv[8];
#pragma unroll
                for (int n = 0; n < 2; ++n)
#pragma unroll
                    for (int e = 0; e < 4; ++e) {
                        const float g = fminf(acc[ai][0][m][n][e] * WSCALE_INV + (n ? g1[e] : g0[e]), 7.0f);
                        const float l = fminf(fmaxf(acc[ai][1][m][n][e] * WSCALE_INV + (n ? u1[e] : u0[e]), -7.0f), 7.0f);
                        hv[n * 4 + e] = g * sigmoidf_fast(1.702f * g) * (l + 1.0f);
                    }
                u32x2 w; w.x = pk4_fp8(hv[0], hv[1], hv[2], hv[3]); w.y = pk4_fp8(hv[4], hv[5], hv[6], hv[7]);
                *(u32x2*)rowp = w;
            }
    }
};
struct Moe2Order {
    int c; MoeTabs tb; const char* H; const char* W;
    __device__ __forceinline__ bool next(int i, Unit& u) const {
        const int x = c & 7, j = c >> 3, tile = 32 * i + 4 * x + (j & 3), pn = j >> 2;
        if (tile >= tb.ntiles) return false;
        const int e = tb.tile_e[tile];
        u.A = H + (size_t)tile * 256 * DFF; u.B = W + ((size_t)e * DM + pn * 256) * DFF; u.row0 = tile * 256; u.col0 = pn * 256; u.tag = e; u.aux = 0; return true;
    }
};
struct EpiMoe2 {
    static constexpr bool PERM = true, WIDE = true;
    const float* bd; bf16_t* Y; LAS unsigned char* scr;
    __device__ __forceinline__ void operator()(const f32x4 (&acc)[2][2][4][2], const Unit& u, int wr, int wc, int fr, int fq) const {
        const int lane = threadIdx.x & 63; LAS unsigned char* my = scr + (threadIdx.x >> 6) * 2304;
        const float* pb = bd + (size_t)u.tag * DM + u.col0 + wc * 64 + 8 * fq;
        f32x4 bv[2][2];
#pragma unroll
        for (int bj = 0; bj < 2; ++bj)
#pragma unroll
            for (int n = 0; n < 2; ++n) bv[bj][n] = *(const f32x4*)(pb + bj * 32 + 4 * n);
        const int colw = u.col0 + wc * 64 + 8 * (lane & 7);
#pragma unroll
        for (int ai = 0; ai < 2; ++ai)
#pragma unroll
            for (int m = 0; m < 4; ++m) {
#pragma unroll
                for (int bj = 0; bj < 2; ++bj) { const f32x4 v0 = acc[ai][bj][m][0] * WSCALE_INV + bv[bj][0], v1 = acc[ai][bj][m][1] * WSCALE_INV + bv[bj][1];
                    u32x4 w; w.x = cvt_pk_bf16(v0[0], v0[1]); w.y = cvt_pk_bf16(v0[2], v0[3]); w.z = cvt_pk_bf16(v1[0], v1[1]); w.w = cvt_pk_bf16(v1[2], v1[3]);
                    *(LAS u32x4*)(my + fr * 144 + bj * 64 + fq * 16) = w; }
#pragma unroll
                for (int hh = 0; hh < 2; ++hh) { const int row = (lane >> 3) + 8 * hh; const u32x4 x = *(const LAS u32x4*)(my + row * 144 + (lane & 7) * 16);
                    *(u32x4*)(Y + (size_t)(u.row0 + ai * 128 + wr * 64 + m * 16 + row) * DM + colw) = x; }
            }
    }
};

namespace attn {
constexpr int NW = 8, QBLK = 32, KVBLK = 64, LDK = 1024;
constexpr int SHM_V = KVBLK * 128 * 2, SHM_K = KVBLK * 128 * 2;
constexpr int OFF_V = 0, OFF_K = 2 * SHM_V, OFF_WS = 2 * SHM_V + 2 * SHM_K, OFF_BIAS = OFF_WS + NW * 64 * 4, OFF_Q = OFF_BIAS + 4096, ATTN_LDS = OFF_Q + 65536;
constexpr float THR = 8.f;
#define KSWZ(row, colB) ((row) * 256 + ((colB) ^ (((row) & 7) << 4)))
#define SBAR() __builtin_amdgcn_sched_barrier(0)
__device__ __forceinline__ int crow(int r, int hi) { return (r & 3) + 8 * (r >> 2) + 4 * hi; }
template <int MODE> struct Cfg { static constexpr float SCALE = MODE == 0 ? 0.08838834764831845f : 0.125f; static constexpr int ND = MODE == 0 ? 8 : 4; };

template <int MODE>
__device__ __forceinline__ void partialSM(f32x16& p0, f32x16& p1, float& m_reg, float& mn, float& alpha) {
    constexpr float SCALE = Cfg<MODE>::SCALE, C = SCALE * 1.4426950408889634f;
    float pmax = p0[0];
#pragma unroll
    for (int r = 1; r < 16; ++r) pmax = fmaxf(pmax, p0[r]);
#pragma unroll
    for (int r = 0; r < 16; ++r) pmax = fmaxf(pmax, p1[r]);
    { auto rr = __builtin_amdgcn_permlane32_swap(__float_as_uint(pmax), __float_as_uint(pmax), false, false);
      pmax = fmaxf(__uint_as_float(rr[0]), __uint_as_float(rr[1])); }
    if (__builtin_expect(__all(pmax - m_reg <= THR / SCALE), 1)) { mn = m_reg; alpha = 1.f; }
    else { mn = fmaxf(m_reg, pmax); alpha = __builtin_amdgcn_exp2f((m_reg - mn) * C); m_reg = mn; }
    const float mnC = -mn * C;
#pragma unroll
    for (int r = 0; r < 16; ++r) p0[r] = fmaf(p0[r], C, mnC);
#pragma unroll
    for (int r = 0; r < 16; ++r) p1[r] = fmaf(p1[r], C, mnC);
#pragma unroll
    for (int r = 0; r < 16; ++r) p0[r] = __builtin_amdgcn_exp2f(p0[r]);
}
__device__ __forceinline__ void finishSM(f32x16& p0, f32x16& p1, float alpha, float& l_reg, bf16x8& pa0, bf16x8& pa1, bf16x8& pa2, bf16x8& pa3) {
#pragma unroll
    for (int r = 0; r < 16; ++r) p1[r] = __builtin_amdgcn_exp2f(p1[r]);
    float ps = 0;
#pragma unroll
    for (int r = 0; r < 16; ++r) ps += p0[r];
#pragma unroll
    for (int r = 0; r < 16; ++r) ps += p1[r];
    { auto rr = __builtin_amdgcn_permlane32_swap(__float_as_uint(ps), __float_as_uint(ps), false, false);
      ps = __uint_as_float(rr[0]) + __uint_as_float(rr[1]); }
    l_reg = l_reg * alpha + ps;
#define PK4(P, BASE, OUT) do { unsigned a0 = cvt_pk_bf16(P[BASE + 0], P[BASE + 1]), a1 = cvt_pk_bf16(P[BASE + 2], P[BASE + 3]);   \
    unsigned b0 = cvt_pk_bf16(P[BASE + 4], P[BASE + 5]), b1 = cvt_pk_bf16(P[BASE + 6], P[BASE + 7]);                              \
    auto r0 = __builtin_amdgcn_permlane32_swap(a0, b0, false, false); auto r1 = __builtin_amdgcn_permlane32_swap(a1, b1, false, false); \
    u32x4 w = {r0[0], r1[0], r0[1], r1[1]}; OUT = *reinterpret_cast<bf16x8*>(&w); } while (0)
    PK4(p0, 0, pa0); PK4(p0, 8, pa1); PK4(p1, 0, pa2); PK4(p1, 8, pa3);
#undef PK4
}
template <int MODE>
__device__ __forceinline__ void qkt(f32x16& p0, f32x16& p1, const LAS unsigned char* Ks, const bf16x8* qr, const LAS unsigned char* Qs, int r32, int hi, int cbase) {
    p0 = f32x16{}; p1 = f32x16{};
#pragma unroll
    for (int d0 = 0; d0 < Cfg<MODE>::ND; ++d0) { const int cb = cbase + (d0 * 16 + hi * 8) * 2;
        const bf16x8 b0 = *(const LAS bf16x8*)(Ks + KSWZ(r32, cb));
        const bf16x8 b1 = *(const LAS bf16x8*)(Ks + KSWZ(32 + r32, cb));
        bf16x8 q; if constexpr (MODE == 0) q = *(const LAS bf16x8*)(Qs + KSWZ(r32, cb)); else q = qr[d0];
        p0 = __builtin_amdgcn_mfma_f32_32x32x16_bf16(b0, q, p0, 0, 0, 0);
        p1 = __builtin_amdgcn_mfma_f32_32x32x16_bf16(b1, q, p1, 0, 0, 0); }
}
__device__ __forceinline__ int v_st(int k, int c) { const int kk = (k & ~0xC) | ((k & 4) << 1) | ((k & 8) >> 1); return ((kk >> 3) * 4 + (c >> 5)) * 512 + ((kk & 7) * 32 + (c & 31)) * 2; }
__device__ __forceinline__ int v_rd_base(int lane) { return ((lane & 3) << 3) | (((lane >> 2) & 3) << 6) | (((lane >> 4) & 1) << 5) | (((lane >> 5) & 1) << 8); }
constexpr int v_rd_off(int d0, int ks, int half) { return d0 * 512 + ks * 4096 + half * 2048; }
template <int OFF> __device__ __forceinline__ s16x4 tr_read(int vb) {
    s16x4 r; asm volatile("ds_read_b64_tr_b16 %0, %1 offset:%2" : "=&v"(r) : "v"(vb), "i"(OFF) : "memory"); return r;
}
template <int D0> __device__ __forceinline__ void pv_one(f32x16& od, int vb, bf16x8 pa0, bf16x8 pa1, bf16x8 pa2, bf16x8 pa3) {
    const s16x4 l0 = tr_read<v_rd_off(D0, 0, 0)>(vb), h0 = tr_read<v_rd_off(D0, 0, 1)>(vb), l1 = tr_read<v_rd_off(D0, 1, 0)>(vb), h1 = tr_read<v_rd_off(D0, 1, 1)>(vb);
    const s16x4 l2 = tr_read<v_rd_off(D0, 2, 0)>(vb), h2 = tr_read<v_rd_off(D0, 2, 1)>(vb), l3 = tr_read<v_rd_off(D0, 3, 0)>(vb), h3 = tr_read<v_rd_off(D0, 3, 1)>(vb);
    asm volatile("s_waitcnt lgkmcnt(0)" ::: "memory"); SBAR();
#define PKV(L, H) (bf16x8){L[0], L[1], L[2], L[3], H[0], H[1], H[2], H[3]}
    od = __builtin_amdgcn_mfma_f32_32x32x16_bf16(pa0, PKV(l0, h0), od, 0, 0, 0);
    od = __builtin_amdgcn_mfma_f32_32x32x16_bf16(pa1, PKV(l1, h1), od, 0, 0, 0);
    od = __builtin_amdgcn_mfma_f32_32x32x16_bf16(pa2, PKV(l2, h2), od, 0, 0, 0);
    od = __builtin_amdgcn_mfma_f32_32x32x16_bf16(pa3, PKV(l3, h3), od, 0, 0, 0);
#undef PKV
}
__device__ __forceinline__ void pv_d0(f32x16* o, int vb, bf16x8 pa0, bf16x8 pa1, bf16x8 pa2, bf16x8 pa3) {
    pv_one<0>(o[0], vb, pa0, pa1, pa2, pa3); pv_one<1>(o[1], vb, pa0, pa1, pa2, pa3); pv_one<2>(o[2], vb, pa0, pa1, pa2, pa3); pv_one<3>(o[3], vb, pa0, pa1, pa2, pa3);
}
__device__ __forceinline__ void na_mask(f32x16& p0, f32x16& p1, bool rowvalid, const LAS float* bp, int tv) {
    asm volatile("" : "+v"(tv));
    if (!rowvalid) {
#pragma unroll
        for (int r = 0; r < 16; ++r) { p0[r] = -1e30f; p1[r] = -1e30f; }
        return;
    }
#pragma unroll
    for (int r = 0; r < 16; ++r) {
        const int c0 = (r & 3) + 8 * (r >> 2);
        float b0 = bp[c0], b1 = bp[c0 + 32];
        asm volatile("" : "+v"(b0), "+v"(b1));
        const float t0 = p0[r] + b0, t1 = p1[r] + b1;
        p0[r] = ((unsigned)(c0 + tv) < 16u) ? t0 : -1e30f;
        p1[r] = ((unsigned)(c0 + 32 + tv) < 16u) ? t1 : -1e30f;
    }
}

template <int MODE>
__device__ __forceinline__ void attn_pass(const bf16_t* __restrict__ Qb, const bf16_t* __restrict__ Kh, const bf16_t* __restrict__ Vh, const int NT, const int kr0, const int g4, const int map,
                                          LAS unsigned char* lds, f32x16 (&o)[4]) {
    constexpr int ND = Cfg<MODE>::ND;
    const int tid = threadIdx.x, wid = tid >> 6, lane = tid & 63, r32 = lane & 31, hi = lane >> 5;
    LAS unsigned char* V_lds = lds + OFF_V; LAS unsigned char* K_lds = lds + OFF_K;
    LAS float* ws = (LAS float*)(lds + OFF_WS) + wid * 64; LAS float* li_l = ws; LAS float* al_l = ws + 32;
    const LAS float* biasL = (const LAS float*)(lds + OFF_BIAS);
    float m_reg = -1e30f, l_reg = 0;
#pragma unroll
    for (int d = 0; d < 4; ++d) o[d] = f32x16{};
    bf16x8 qr[ND];
    const bf16_t* Qw = Qb + (long)(wid * QBLK + r32) * LDK + hi * 8;
    LAS unsigned char* Qs = lds + OFF_Q + wid * (QBLK * 256);
#pragma unroll
    for (int d0 = 0; d0 < ND; ++d0) { qr[d0] = *(const bf16x8*)(Qw + d0 * 16); if constexpr (MODE == 0) *(LAS bf16x8*)(Qs + KSWZ(r32, (d0 * 16 + hi * 8) * 2)) = qr[d0]; }
    const int cbase = MODE == 1 ? map * 128 : 0;
    const int sr = tid >> 4, sc = (tid & 15) * 8, vst0 = v_st(sr, sc), vst1 = v_st(32 + sr, sc);
    const int vb0 = (int)(uintptr_t)V_lds + v_rd_base(lane);
    const int qR = g4 * 4 + (wid >> 1), qc = 32 * (wid & 1) + r32, cs = qc < 8 ? 0 : (qc > 56 ? 48 : qc - 8);
    const int r0w = qR < 4 ? 0 : (qR > 60 ? 56 : qR - 4);
    struct { bf16x8 vs0, vs1, ks0, ks1; } sr_[2];
#define TROW(jt) (MODE == 0 ? ((jt) < 4 ? SEQ + 64 * (jt) : (kr0 + (jt) - 4) * 64) : 64 * (jt))
#define SLOAD(i, jt) do { const long k0_ = TROW(jt); sr_[i].vs0 = *(const bf16x8*)(&Vh[(k0_ + sr) * LDK + sc]); sr_[i].vs1 = *(const bf16x8*)(&Vh[(k0_ + 32 + sr) * LDK + sc]); \
    sr_[i].ks0 = *(const bf16x8*)(&Kh[(k0_ + sr) * LDK + sc]); sr_[i].ks1 = *(const bf16x8*)(&Kh[(k0_ + 32 + sr) * LDK + sc]); } while (0)
#define SWRITE(b, i) do { *(LAS bf16x8*)(V_lds + (b) * SHM_V + vst0) = sr_[i].vs0; *(LAS bf16x8*)(V_lds + (b) * SHM_V + vst1) = sr_[i].vs1; const int kc_ = sc * 2; \
    *(LAS bf16x8*)(K_lds + (b) * SHM_K + KSWZ(sr, kc_)) = sr_[i].ks0; *(LAS bf16x8*)(K_lds + (b) * SHM_K + KSWZ(32 + sr, kc_)) = sr_[i].ks1; } while (0)
#define SWAIT() asm volatile("s_waitcnt vmcnt(4)" ::: "memory")
#define RESC(a) do { if (__any((a) < 1.f)) { if (hi == 0) al_l[r32] = (a); asm volatile("s_waitcnt lgkmcnt(0)" ::: "memory"); \
    _Pragma("unroll") for (int d = 0; d < 4; ++d) _Pragma("unroll") for (int r = 0; r < 16; ++r) o[d][r] *= al_l[crow(r, hi)]; } } while (0)
#define MASK(P0, P1, jt) do { if (MODE == 0 && (jt) >= 4) { const int kr_ = kr0 + (jt) - 4; const bool rv_ = (kr_ >= r0w) && (kr_ < r0w + 8); int br_ = kr_ - qR + 7; br_ = br_ < 0 ? 0 : (br_ > 14 ? 14 : br_); \
    na_mask(P0, P1, rv_, biasL + 64 + br_ * 32 + (4 * hi - qc + 15), 4 * hi - cs); } } while (0)
    f32x16 pA0, pA1, pB0, pB1; float mnA, mnB, alA, alB; bf16x8 pa0, pa1, pa2, pa3;
    constexpr int SE = 0, SO = 1;
    SLOAD(SE, 0); asm volatile("s_waitcnt vmcnt(0)" ::: "memory"); SWRITE(0, SE); __syncthreads();
    qkt<MODE>(pA0, pA1, K_lds, qr, Qs, r32, hi, cbase); MASK(pA0, pA1, 0); partialSM<MODE>(pA0, pA1, m_reg, mnA, alA);
    SLOAD(SO, 1); if (2 < NT) SLOAD(SE, 2);
    SWAIT(); SWRITE(1, SO); __syncthreads();
    for (int j = 1; j + 1 < NT; j += 2) {
        SBAR(); qkt<MODE>(pB0, pB1, K_lds + SHM_K, qr, Qs, r32, hi, cbase); MASK(pB0, pB1, j);
        finishSM(pA0, pA1, alA, l_reg, pa0, pa1, pa2, pa3); SBAR();
        SLOAD(SO, j + 2 < NT ? j + 2 : NT - 1); SBAR();
        pv_d0(o, vb0, pa0, pa1, pa2, pa3); partialSM<MODE>(pB0, pB1, m_reg, mnB, alB);
        __syncthreads(); SWAIT(); SWRITE(0, SE);
        RESC(alB); __syncthreads();
        SBAR(); qkt<MODE>(pA0, pA1, K_lds, qr, Qs, r32, hi, cbase); MASK(pA0, pA1, j + 1);
        finishSM(pB0, pB1, alB, l_reg, pa0, pa1, pa2, pa3); SBAR();
        if (j + 3 < NT) SLOAD(SE, j + 3); SBAR();
        pv_d0(o, vb0 + SHM_V, pa0, pa1, pa2, pa3); partialSM<MODE>(pA0, pA1, m_reg, mnA, alA);
        __syncthreads(); SWAIT(); SWRITE(1, SO);
        RESC(alA); __syncthreads();
    }
    SBAR(); qkt<MODE>(pB0, pB1, K_lds + SHM_K, qr, Qs, r32, hi, cbase); MASK(pB0, pB1, NT - 1);
    finishSM(pA0, pA1, alA, l_reg, pa0, pa1, pa2, pa3); SBAR();
    pv_d0(o, vb0, pa0, pa1, pa2, pa3); partialSM<MODE>(pB0, pB1, m_reg, mnB, alB);
    __syncthreads(); RESC(alB);
    finishSM(pB0, pB1, alB, l_reg, pa0, pa1, pa2, pa3); SBAR();
    pv_d0(o, vb0 + SHM_V, pa0, pa1, pa2, pa3);
    if (hi == 0) li_l[r32] = l_reg; asm volatile("s_waitcnt lgkmcnt(0)" ::: "memory");
#pragma unroll
    for (int r = 0; r < 16; ++r) { const float rl = __builtin_amdgcn_rcpf(li_l[crow(r, hi)]);
#pragma unroll
        for (int d = 0; d < 4; ++d) o[d][r] *= rl; }
    __syncthreads();
#undef TROW
#undef SLOAD
#undef SWRITE
#undef SWAIT
#undef RESC
#undef MASK
}
}

__device__ __forceinline__ void p0_adaln(Frame& F) {
    LAS float* sil = (LAS float*)(F.lds + 71680); LAS float* red = sil + 3 * 2048;
    const float* c = F.in[I_C]; const float* cc = F.in[I_CCTX];
    for (int i = F.tid; i < 3 * 2048; i += 512) { const int r = i >> 11, k = i & 2047; const float v = r < 2 ? c[r * 2048 + k] : cc[k]; sil[i] = v / (1.0f + expf(-v)); }
    __syncthreads();
    const int c0 = blockIdx.x * 64, kq = F.lane >> 4, cq = F.lane & 15;
    float acc[3][4];
#pragma unroll
    for (int r = 0; r < 3; ++r)
#pragma unroll
        for (int e = 0; e < 4; ++e) acc[r][e] = 0.f;
    const float* wp = F.in[I_WADA] + (size_t)(256 * F.wave + kq) * 12288 + c0 + 4 * cq;
#pragma unroll 8
    for (int it = 0; it < 64; ++it) {
        const int k = 256 * F.wave + 4 * it + kq;
        const f32x4 w = *(const f32x4*)(wp + (size_t)it * 4 * 12288);
        const float s0 = sil[k], s1 = sil[2048 + k], s2 = sil[4096 + k];
#pragma unroll
        for (int e = 0; e < 4; ++e) { acc[0][e] += s0 * w[e]; acc[1][e] += s1 * w[e]; acc[2][e] += s2 * w[e]; }
    }
#pragma unroll
    for (int r = 0; r < 3; ++r)
#pragma unroll
        for (int e = 0; e < 4; ++e) { float v = acc[r][e]; v += __shfl_xor(v, 16); v += __shfl_xor(v, 32); if (kq == 0) red[(F.wave * 3 + r) * 64 + 4 * cq + e] = v; }
    __syncthreads();
    if (F.tid < 192) { const int r = F.tid >> 6, q = F.tid & 63; float s = F.in[I_BADA][c0 + q];
#pragma unroll
        for (int w = 0; w < 8; ++w) s += red[(w * 3 + r) * 64 + q];
        ((float*)(F.ws + WS_MOD))[r * 12288 + c0 + q] = s; }
    __syncthreads();
}
__device__ __forceinline__ unsigned f2bf(float f) { unsigned u = __float_as_uint(f); return (u + 0x7fffu + ((u >> 16) & 1u)) >> 16; }
__device__ __forceinline__ unsigned pk2(float lo, float hi) { return f2bf(lo) | (f2bf(hi) << 16); }
__device__ __forceinline__ void p0_transpose_item(const float* W, int N, int k0, int n0, bf16_t* dst, int dK, bool rope_perm, LAS float* scr, int lane) {
#pragma unroll 8
    for (int i = 0; i < 32; ++i) { const int kk = 2 * i + (lane >> 5); scr[kk * 33 + (lane & 31)] = W[(size_t)(k0 + kk) * N + n0 + (lane & 31)]; }
    LDS_WAIT(); asm volatile("" ::: "memory");
    const int c = lane & 7;
#pragma unroll
    for (int j = 0; j < 4; ++j) { const int n = (lane >> 3) + 8 * j; const int ns = rope_perm ? (16 * ((n >> 2) & 1) + 4 * (n >> 3) + (n & 3)) : n; const LAS float* s = scr + (8 * c) * 33 + ns;
        u32x4 o; o.x = pk2(s[0 * 33], s[1 * 33]); o.y = pk2(s[2 * 33], s[3 * 33]); o.z = pk2(s[4 * 33], s[5 * 33]); o.w = pk2(s[6 * 33], s[7 * 33]);
        *(u32x4*)(dst + (size_t)n * dK + k0 + 8 * c) = o; }
    LDS_WAIT(); asm volatile("" ::: "memory");
}
struct MoeItem { const float* src; unsigned char* dst; int stride; };
constexpr int MOE_IE = 16 * 64;
constexpr int NMOE_X = 96 * MOE_IE, NGATE_IT = 16 * 128, NWO_IT = 16 * 64;
__device__ __forceinline__ MoeItem moe_item(const float* wg, const float* wu, const float* wd, const float* win, const float* wout, unsigned char* ws, int r, int lane) {
    if (r >= NMOE_X + NGATE_IT) { const int q = r - NMOE_X - NGATE_IT, kb = q >> 6, nb = q & 63; MoeItem it; it.stride = DM;
        it.src = wout + (size_t)(kb * 128 + (lane >> 5)) * DM + nb * 32 + (lane & 31);
        it.dst = ws + WS_WO8 + (size_t)(nb * 32) * DM + kb * 128 + (size_t)(lane >> 3) * DM + 16 * (lane & 7); return it; }
    if (r >= NMOE_X) { const int q = r - NMOE_X, kb = q >> 7, nb = q & 127; MoeItem it; it.stride = INC;
        it.src = win + (size_t)(kb * 128 + (lane >> 5)) * INC + 6144 + nb * 32 + (lane & 31);
        it.dst = ws + WS_WG8 + (size_t)(nb * 32) * DM + kb * 128 + (size_t)(lane >> 3) * DM + 16 * (lane & 7); return it; }
    const int mat = r / MOE_IE, q = r % MOE_IE, e = mat / 3, which = mat % 3, kb = q / 64, nb = q % 64, n0 = nb * 32;
    const float* src = (which == 0 ? wg : (which == 1 ? wu : wd)) + (size_t)e * DM * DFF + (size_t)(kb * 128 + (lane >> 5)) * DFF + n0 + (lane & 31);
    unsigned char* dst;
    if (which < 2) dst = ws + WS_WGUT + ((size_t)(e * 16 + (n0 >> 7)) * 256 + which * 128 + (n0 & 127)) * DM;
    else dst = ws + WS_WDT + ((size_t)e * DM + n0) * DFF;
    MoeItem it; it.stride = DFF; it.src = src; it.dst = dst + kb * 128 + (size_t)(lane >> 3) * DM + 16 * (lane & 7); return it;
}
#define MOE_LOAD(v, it) do { _Pragma("unroll") for (int i_ = 0; i_ < 64; ++i_) v[i_] = __builtin_nontemporal_load((it).src + (size_t)(2 * i_) * (it).stride); } while (0)
#define MOE_PROC(v, it) do { _Pragma("unroll") for (int i_ = 0; i_ < 64; ++i_) { const int k_ = 2 * i_ + (F.lane >> 5); scr[k_ * 32 + ((F.lane & 31) ^ (4 * (k_ >> 4)))] = v[i_]; } \
    LDS_WAIT(); asm volatile("" ::: "memory"); \
    _Pragma("unroll") for (int j_ = 0; j_ < 4; ++j_) { const int c_ = F.lane & 7; const LAS float* s_ = scr + (16 * c_) * 32 + (((F.lane >> 3) + 8 * j_) ^ (4 * c_)); \
        u32x4 o_; o_.x = pk4_fp8(s_[0 * 32] * WSCALE, s_[1 * 32] * WSCALE, s_[2 * 32] * WSCALE, s_[3 * 32] * WSCALE); o_.y = pk4_fp8(s_[4 * 32] * WSCALE, s_[5 * 32] * WSCALE, s_[6 * 32] * WSCALE, s_[7 * 32] * WSCALE); \
        o_.z = pk4_fp8(s_[8 * 32] * WSCALE, s_[9 * 32] * WSCALE, s_[10 * 32] * WSCALE, s_[11 * 32] * WSCALE); o_.w = pk4_fp8(s_[12 * 32] * WSCALE, s_[13 * 32] * WSCALE, s_[14 * 32] * WSCALE, s_[15 * 32] * WSCALE); \
        if (moe_store || o_.x == 0x12345678u) __builtin_nontemporal_store(o_, (u32x4*)((it).dst + (size_t)(8 * j_) * DM)); } \
    LDS_WAIT(); asm volatile("" ::: "memory"); } while (0)
__device__ __forceinline__ void p0_convert(Frame& F, const int parts = 7, const bool moe_store = true) {
    LAS float* scr = (LAS float*)(F.lds + F.wave * 16384);
    const int gw = F.vcu * 8 + F.wave, NGW = F.G * 8;
    constexpr int I_IN = 32 * 320, I_P = 16 * 64, I_O = 32 * 64, I_E = 32 * 64;
    constexpr int NSMALL = I_IN + 2 * I_P, NMOE = NMOE_X + NGATE_IT + NWO_IT;
    if (parts & 1) for (int it = gw; it < NSMALL; it += NGW) {
        int r = it;
        if (r < I_IN) { const int kb = r / 320, nb = r % 320, n0 = nb * 32; const int t = n0 >> 10;
            if (t < 6) p0_transpose_item(F.in[I_WIN], INC, kb * 64, n0, (bf16_t*)(F.ws + WS_WINT) + (size_t)n0 * DM, DM, t == 2 || t == 5, scr, F.lane); continue; } r -= I_IN;
        if (r < I_P) { const int kb = r / 64, nb = r % 64; p0_transpose_item(F.in[I_WPNA], DM, kb * 64, nb * 32, (bf16_t*)(F.ws + WS_WPNAT) + (size_t)nb * 32 * 1024, 1024, false, scr, F.lane); continue; } r -= I_P;
        { const int kb = r / 64, nb = r % 64; p0_transpose_item(F.in[I_WPDF], DM, kb * 64, nb * 32, (bf16_t*)(F.ws + WS_WPDFT) + (size_t)nb * 32 * 1024, 1024, false, scr, F.lane); }
    }
    if (parts & 2) {
        const float* wg = F.in[I_WG]; const float* wu = F.in[I_WU]; const float* wd = F.in[I_WD]; const float* win = F.in[I_WIN]; const float* wout = F.in[I_WOUT];
        float va[64], vb[64];
        const int nmine = (NMOE - gw + NGW - 1) / NGW;
        const int last = gw + (nmine - 1) * NGW;
        MoeItem ia = moe_item(wg, wu, wd, win, wout, F.ws, gw, F.lane), ib = ia;
        MOE_LOAD(va, ia);
        for (int j = 0; j < nmine; j += 2) {
            const int it1 = gw + (j + 1) * NGW, it2 = gw + (j + 2) * NGW;
            ib = moe_item(wg, wu, wd, win, wout, F.ws, it1 <= last ? it1 : last, F.lane); MOE_LOAD(vb, ib);
            MOE_PROC(va, ia);
            ia = moe_item(wg, wu, wd, win, wout, F.ws, it2 <= last ? it2 : last, F.lane); MOE_LOAD(va, ia);
            MOE_PROC(vb, ib);
        }
    }
    const int gt = F.vcu * 512 + F.tid, NGT = F.G * 512;
    if (parts & 4) for (int i = gt; i < 32 * 2048; i += NGT) { const int e = i >> 11, k = i & 2047; const float w = F.in[I_WR][k * 32 + e]; const unsigned hb = f2bf(w); const float lo = w - __uint_as_float(hb << 16);
        ((bf16_t*)(F.ws + WS_WRT))[i] = (bf16_t)hb; ((bf16_t*)(F.ws + WS_WRT))[65536 + i] = (bf16_t)f2bf(lo); }
    if ((parts & 4) && gt < 1024) { const int pos = gt >> 4, i = gt & 15; const float inv = exp2f(-(float)i * (13.287712379549449f / 16.0f)); const float a = (float)pos * inv;
        const float n = rintf(a * 0.15915494309189535f); float rr = fmaf(-n, 6.2831854820251465f, a); rr = fmaf(-n, -1.7484555e-7f, rr);
        ((f32x2*)(F.ws + WS_ROPE))[gt] = (f32x2){__cosf(rr), __sinf(rr)}; }
}

__device__ __forceinline__ void p1_ln_mod(Frame& F) {
    const int gw = F.vcu * 8 + F.wave, NGW = F.G * 8; const float* mod = (const float*)(F.ws + WS_MOD);
    for (int m = gw; m < MTOT; m += NGW) {
        const int b = m / RPB, idx = m % RPB; const float* src; const float* md;
        if (idx < SEQ) { src = F.in[I_X] + (size_t)(b * SEQ + idx) * DM; md = mod + (size_t)b * 12288; } else { src = F.in[I_CTX] + (size_t)(b * CTXL + idx - SEQ) * DM; md = mod + 2 * 12288; }
        const f32x4* xr = (const f32x4*)src + F.lane; f32x4 v[8]; float s = 0.f;
#pragma unroll
        for (int j = 0; j < 8; ++j) { v[j] = xr[64 * j]; s += (v[j][0] + v[j][1]) + (v[j][2] + v[j][3]); }
        const float mean = wave_sum(s) * (1.f / DM); float s2 = 0.f;
#pragma unroll
        for (int j = 0; j < 8; ++j) { v[j] = v[j] - mean; s2 += (v[j][0] * v[j][0] + v[j][1] * v[j][1]) + (v[j][2] * v[j][2] + v[j][3] * v[j][3]); }
        const float rstd = 1.f / sqrtf(wave_sum(s2) * (1.f / DM) + LN_EPS);
        u32x2* o8 = (u32x2*)((bf16_t*)(F.ws + WS_U) + (size_t)m * DM) + F.lane;
#pragma unroll
        for (int j = 0; j < 8; ++j) { const f32x4 sh = ((const f32x4*)md)[F.lane + 64 * j], sc = ((const f32x4*)(md + 2048))[F.lane + 64 * j];
            const f32x4 y = v[j] * rstd * (sc + 1.0f) + sh; u32x2 w; w.x = cvt_pk_bf16(y[0], y[1]); w.y = cvt_pk_bf16(y[2], y[3]); o8[64 * j] = w;
            ((unsigned*)(F.ws + WS_UF8 + (size_t)m * DM))[F.lane + 64 * j] = pk4_fp8(y[0], y[1], y[2], y[3]); }
    }
}

__device__ __forceinline__ void p3_attention(Frame& F) {
    const int c = blockIdx.x; if (c >= 256) return;
    const int xcd = c & 7, j = c >> 3, bh = xcd * 2 + (j >> 4), qb = j & 15, b = bh >> 3, h = bh & 7;
    const bf16_t* KV = (const bf16_t*)(F.ws + WS_KV);
    f32x16 o[4];
    const int tid = F.tid, wid = tid >> 6, lane = tid & 63, r32 = lane & 31, hi = lane >> 5;
#ifndef NO_DIFF
    float lam;
    { float d1 = 0.f, d2 = 0.f;
      for (int i = 0; i < 64; ++i) { d1 += F.in[I_LQ1][i] * F.in[I_LK1][i]; d2 += F.in[I_LQ2][i] * F.in[I_LK2][i]; }
      lam = expf(d1) - expf(d2) + LAM_INIT; }
    {
        const bf16_t* Kh = KV + 2 * (KV_STRIDE / 2) + (size_t)b * RPB * 1024 + h * 128;
        const bf16_t* Vh = KV + 3 * (KV_STRIDE / 2) + (size_t)b * RPB * 1024 + h * 128;
        const bf16_t* Qb = (const bf16_t*)(F.ws + WS_QDF) + (size_t)(b * SEQ + qb * 256) * 1024 + h * 128;
        f32x4* o1s = (f32x4*)((float*)(F.ws + WS_O1S) + ((size_t)c * 512 + tid) * 64);
        attn::attn_pass<1>(Qb, Kh, Vh, RPB / 64, 0, 0, 0, F.lds, o);
#pragma unroll
        for (int d = 0; d < 4; ++d)
#pragma unroll
            for (int q = 0; q < 4; ++q) o1s[d * 4 + q] = (f32x4){o[d][4 * q], o[d][4 * q + 1], o[d][4 * q + 2], o[d][4 * q + 3]};
        attn::attn_pass<1>(Qb + 64, Kh, Vh, RPB / 64, 0, 0, 1, F.lds, o);
        float sw[4];
#pragma unroll
        for (int d = 0; d < 4; ++d) sw[d] = F.in[I_SUBLN][d * 32 + r32] * (1.0f - LAM_INIT);
        bf16_t* od = (bf16_t*)(F.ws + WS_ODF) + (size_t)(b * SEQ + qb * 256 + wid * 32) * 1024 + h * 128 + r32;
#pragma unroll
        for (int r = 0; r < 16; ++r) {
            float dd[4], ss = 0.f;
#pragma unroll
            for (int d = 0; d < 4; ++d) { dd[d] = o1s[d * 4 + (r >> 2)][r & 3] - lam * o[d][r]; ss += dd[d] * dd[d]; }
            ss += __shfl_xor(ss, 1); ss += __shfl_xor(ss, 2); ss += __shfl_xor(ss, 4); ss += __shfl_xor(ss, 8); ss += __shfl_xor(ss, 16);
            const float rs = 1.0f / sqrtf(ss * (1.0f / 128.0f) + RMS_EPS);
            bf16_t* orow = od + (size_t)attn::crow(r, hi) * 1024;
#pragma unroll
            for (int d = 0; d < 4; ++d) orow[d * 32] = (bf16_t)f2bf(dd[d] * rs * sw[d]);
        }
    }
#endif
#ifndef NO_NA
    {
        const int g4 = qb, kr0 = (4 * g4 - 4) < 0 ? 0 : ((4 * g4 - 4) > 52 ? 52 : 4 * g4 - 4);
        LAS float* biasL = (LAS float*)(F.lds + attn::OFF_BIAS);
        for (int i = tid; i < 15 * 32; i += 512) { const int rr = i >> 5, cc = i & 31; biasL[64 + i] = cc < 31 ? F.in[I_RELB][(h * 15 + rr) * 31 + cc] * (1.0f / attn::Cfg<0>::SCALE) : 0.f; }
        __syncthreads();
        const bf16_t* Kh = KV + (size_t)b * RPB * 1024 + h * 128;
        const bf16_t* Vh = KV + 1 * (KV_STRIDE / 2) + (size_t)b * RPB * 1024 + h * 128;
        const bf16_t* Qb = (const bf16_t*)(F.ws + WS_QNA) + (size_t)(b * SEQ + g4 * 256) * 1024 + h * 128;
        attn::attn_pass<0>(Qb, Kh, Vh, 16, kr0, g4, 0, F.lds, o);
        int hi2 = hi, r32b = r32; asm volatile("" : "+v"(hi2), "+v"(r32b));
        bf16_t* od = (bf16_t*)(F.ws + WS_ONA) + (size_t)(b * SEQ + g4 * 256 + wid * 32) * 1024 + h * 128 + r32b;
#pragma unroll
        for (int r = 0; r < 16; ++r) { bf16_t* orow = od + (size_t)attn::crow(r, hi2) * 1024;
#pragma unroll
            for (int d = 0; d < 4; ++d) orow[d * 32] = (bf16_t)f2bf(o[d][r]); }
    }
#endif
}

__device__ __forceinline__ void p6_router(Frame& F) {
    const int t0 = blockIdx.x * 32; if (t0 >= NTOK) return;
    const float* mod = (const float*)(F.ws + WS_MOD);
    const int b = t0 >> 12, lane = F.lane, wave = F.wave, tid = F.tid;
    const float* Z = (const float*)(F.ws + WS_Z); float* X1 = (float*)(F.ws + WS_X1);
    bf16_t* U2H = (bf16_t*)(F.ws + WS_U2H); bf16_t* U2L = (bf16_t*)(F.ws + WS_U2L); unsigned* U2F = (unsigned*)(F.ws + WS_U2F);
    {
        f32x4 pw[8], pb[8];
#pragma unroll
        for (int j = 0; j < 8; ++j) { pw[j] = ((const f32x4*)F.in[I_LN1W])[lane + 64 * j]; pb[j] = ((const f32x4*)F.in[I_LN1B])[lane + 64 * j]; }
        for (int rp = 0; rp < 2; ++rp) {
            const int ta = t0 + wave * 4 + 2 * rp;
            f32x4 v2[2][8];
#pragma unroll
            for (int q = 0; q < 2; ++q)
#pragma unroll
                for (int j = 0; j < 8; ++j) v2[q][j] = ((const f32x4*)(Z + (size_t)(ta + q) * DM))[lane + 64 * j];
#pragma unroll
            for (int q = 0; q < 2; ++q) {
                const int t = ta + q; f32x4 (&v)[8] = v2[q]; float s = 0.f;
#pragma unroll
                for (int j = 0; j < 8; ++j) s += (v[j][0] + v[j][1]) + (v[j][2] + v[j][3]);
                float mean = wave_sum(s) * (1.f / DM), s2 = 0.f;
#pragma unroll
                for (int j = 0; j < 8; ++j) { v[j] = v[j] - mean; s2 += (v[j][0] * v[j][0] + v[j][1] * v[j][1]) + (v[j][2] * v[j][2] + v[j][3] * v[j][3]); }
                float rstd = 1.f / sqrtf(wave_sum(s2) * (1.f / DM) + LN_EPS);
                s = 0.f;
#pragma unroll
                for (int j = 0; j < 8; ++j) { v[j] = v[j] * rstd * pw[j] + pb[j]; ((f32x4*)(X1 + (size_t)t * DM))[lane + 64 * j] = v[j]; s += (v[j][0] + v[j][1]) + (v[j][2] + v[j][3]); }
                mean = wave_sum(s) * (1.f / DM); s2 = 0.f;
#pragma unroll
                for (int j = 0; j < 8; ++j) { v[j] = v[j] - mean; s2 += (v[j][0] * v[j][0] + v[j][1] * v[j][1]) + (v[j][2] * v[j][2] + v[j][3] * v[j][3]); }
                rstd = 1.f / sqrtf(wave_sum(s2) * (1.f / DM) + LN_EPS);
#pragma unroll
                for (int j = 0; j < 8; ++j) { const f32x4 sh = ((const f32x4*)(mod + (size_t)b * 12288 + 6144))[lane + 64 * j], sc = ((const f32x4*)(mod + (size_t)b * 12288 + 8192))[lane + 64 * j];
                    const f32x4 y = v[j] * rstd * (sc + 1.0f) + sh;
                    u32x2 wh; wh.x = cvt_pk_bf16(y[0], y[1]); wh.y = cvt_pk_bf16(y[2], y[3]);
                    const f32x4 yl = {y[0] - bf_lo(wh.x), y[1] - bf_hi(wh.x), y[2] - bf_lo(wh.y), y[3] - bf_hi(wh.y)};
                    u32x2 wl; wl.x = cvt_pk_bf16(yl[0], yl[1]); wl.y = cvt_pk_bf16(yl[2], yl[3]);
                    ((u32x2*)(U2H + (size_t)t * DM))[lane + 64 * j] = wh; ((u32x2*)(U2L + (size_t)t * DM))[lane + 64 * j] = wl;
                    U2F[(size_t)t * (DM / 4) + lane + 64 * j] = pk4_fp8(y[0], y[1], y[2], y[3]); }
            }
        }
    }
    __syncthreads();
    const bf16_t* WRH = (const bf16_t*)(F.ws + WS_WRT); const bf16_t* WRL = WRH + 65536;
    f32x4 acc[2][2];
#pragma unroll
    for (int a = 0; a < 2; ++a)
#pragma unroll
        for (int n = 0; n < 2; ++n) acc[a][n] = (f32x4){0.f, 0.f, 0.f, 0.f};
    const int fr = lane & 15, fq = lane >> 4;
#pragma unroll 2
    for (int ks = 0; ks < 8; ++ks) {
        const int k0 = wave * 256 + ks * 32 + fq * 8;
        bf16x8 ah[2], al[2], bh[2], bl[2];
#pragma unroll
        for (int a = 0; a < 2; ++a) { ah[a] = *(const bf16x8*)(U2H + (size_t)(t0 + 16 * a + fr) * DM + k0); al[a] = *(const bf16x8*)(U2L + (size_t)(t0 + 16 * a + fr) * DM + k0); }
#pragma unroll
        for (int n = 0; n < 2; ++n) { bh[n] = *(const bf16x8*)(WRH + (size_t)(16 * n + fr) * DM + k0); bl[n] = *(const bf16x8*)(WRL + (size_t)(16 * n + fr) * DM + k0); }
#pragma unroll
        for (int a = 0; a < 2; ++a)
#pragma unroll
            for (int n = 0; n < 2; ++n) {
                acc[a][n] = __builtin_amdgcn_mfma_f32_16x16x32_bf16(ah[a], bh[n], acc[a][n], 0, 0, 0);
                acc[a][n] = __builtin_amdgcn_mfma_f32_16x16x32_bf16(ah[a], bl[n], acc[a][n], 0, 0, 0);
                acc[a][n] = __builtin_amdgcn_mfma_f32_16x16x32_bf16(al[a], bh[n], acc[a][n], 0, 0, 0);
            }
    }
    LAS float* red = (LAS float*)F.lds;
    LAS float* lg = red + 8 * 1024;
    LAS int* aE = (LAS int*)(lg + 1024); LAS int* aP = aE + 128; LAS float* aW = (LAS float*)(aP + 128);
#pragma unroll
    for (int a = 0; a < 2; ++a)
#pragma unroll
        for (int n = 0; n < 2; ++n)
#pragma unroll
            for (int i = 0; i < 4; ++i) red[wave * 1024 + (16 * a + 4 * fq + i) * 32 + 16 * n + fr] = acc[a][n][i];
    __syncthreads();
    for (int i = tid; i < 1024; i += 512) { float s = F.in[I_BR][i & 31];
#pragma unroll
        for (int w = 0; w < 8; ++w) s += red[w * 1024 + i];
        lg[i] = s; }
    __syncthreads();
    for (int pass = 0; pass < 2; ++pass) {
        const int row = pass * 16 + (tid >> 5), e = tid & 31;
        float v = lg[row * 32 + e]; float tl[4]; int te[4];
#pragma unroll
        for (int k = 0; k < 4; ++k) {
            float bv = v; int bi = e;
#pragma unroll
            for (int o = 16; o >= 1; o >>= 1) { const float ov = __shfl_xor(bv, o); const int oi = __shfl_xor(bi, o); if (ov > bv || (ov == bv && oi < bi)) { bv = ov; bi = oi; } }
            tl[k] = bv; te[k] = bi; if (e == bi) v = -INFINITY;
        }
        if (e == 0) { const float e1 = expf(tl[1] - tl[0]), e2 = expf(tl[2] - tl[0]), e3 = expf(tl[3] - tl[0]); const float inv = 1.0f / (1.0f + e1 + e2 + e3);
            aE[row * 4 + 0] = te[0]; aE[row * 4 + 1] = te[1]; aE[row * 4 + 2] = te[2]; aE[row * 4 + 3] = te[3];
            aW[row * 4 + 0] = inv; aW[row * 4 + 1] = e1 * inv; aW[row * 4 + 2] = e2 * inv; aW[row * 4 + 3] = e3 * inv; }
    }
    __syncthreads();
    LAS int* lc = (LAS int*)(aW + 128);
    if (tid < 32) lc[tid] = 0;
    __syncthreads();
    int myE = 0, myR = 0;
    if (tid < 128) { myE = aE[tid]; myR = __hip_atomic_fetch_add(lc + myE, 1, __ATOMIC_RELAXED, __HIP_MEMORY_SCOPE_WORKGROUP); }
    __syncthreads();
    if (tid < 32) { const int n = lc[tid]; lc[32 + tid] = n > 0 ? (int)__hip_atomic_fetch_add(F.ctl + CW_CNT + 64 * tid, (unsigned)n, RLX_AGENT) : 0; }
    __syncthreads();
    if (tid < 128) { const int pos = lc[32 + myE] + myR;
        ((int*)(F.ws + WS_TOKL))[myE * NTOK + pos] = t0 + (tid >> 2);
        ((int*)(F.ws + WS_ASG_E))[t0 * 4 + tid] = myE; ((int*)(F.ws + WS_ASG_P))[t0 * 4 + tid] = pos; ((float*)(F.ws + WS_ASG_W))[t0 * 4 + tid] = aW[tid]; }
}

__device__ __forceinline__ MoeTabs moe_tables(Frame& F) {
    LAS int* tab = (LAS int*)(F.lds + TAB_OFF);
    if (F.tid < 32) tab[320 + F.tid] = (int)__hip_atomic_load(F.ctl + CW_CNT + 64 * F.tid, RLX_AGENT);
    __syncthreads();
    if (F.tid == 0) { int nt = 0;
        for (int e = 0; e < NEXP; ++e) { const int n = (tab[320 + e] + 255) >> 8; tab[352 + e] = nt; for (int r = 0; r < n; ++r) { tab[nt] = e; tab[160 + nt] = r; ++nt; } }
        tab[384] = nt; }
    __syncthreads();
    MoeTabs tb; tb.tile_e = tab; tb.tile_r = tab + 160; tb.tokl = tab + 512; tb.ntiles = tab[384];
    return tb;
}

__device__ __forceinline__ void p9_final(Frame& F) {
    const LAS int* tab = (const LAS int*)(F.lds + TAB_OFF);
    const int gw = F.vcu * 8 + F.wave, NGW = F.G * 8, lane = F.lane; const float* mod = (const float*)(F.ws + WS_MOD);
    const float* X1 = (const float*)(F.ws + WS_X1); const bf16_t* Y = (const bf16_t*)(F.ws + WS_Y);
    for (int t = gw; t < NTOK; t += NGW) {
        const int b = t >> 12;
        const i32x4 ae = ((const i32x4*)(F.ws + WS_ASG_E))[t], ap = ((const i32x4*)(F.ws + WS_ASG_P))[t]; const f32x4 aw = ((const f32x4*)(F.ws + WS_ASG_W))[t];
        const u32x2* yr[4];
#pragma unroll
        for (int k = 0; k < 4; ++k) yr[k] = (const u32x2*)(Y + ((size_t)tab[352 + ae[k]] * 256 + ap[k]) * DM) + lane;
        u32x2 q[4][8]; f32x4 x1[8];
#pragma unroll
        for (int k = 0; k < 4; ++k)
#pragma unroll
            for (int j = 0; j < 8; ++j) q[k][j] = yr[k][64 * j];
#pragma unroll
        for (int j = 0; j < 8; ++j) x1[j] = ((const f32x4*)(X1 + (size_t)t * DM))[lane + 64 * j];
        float s = 0.f; f32x4 v[8];
#pragma unroll
        for (int j = 0; j < 8; ++j) { f32x4 y = {0.f, 0.f, 0.f, 0.f};
#pragma unroll
            for (int k = 0; k < 4; ++k) { const float w = aw[k]; y[0] += w * bf_lo(q[k][j].x); y[1] += w * bf_hi(q[k][j].x); y[2] += w * bf_lo(q[k][j].y); y[3] += w * bf_hi(q[k][j].y); }
            v[j] = x1[j] * DN_ALPHA + ((const f32x4*)(mod + (size_t)b * 12288 + 10240))[lane + 64 * j] * y; s += (v[j][0] + v[j][1]) + (v[j][2] + v[j][3]); }
        const float mean = wave_sum(s) * (1.f / DM); float s2 = 0.f;
#pragma unroll
        for (int j = 0; j < 8; ++j) { v[j] = v[j] - mean; s2 += (v[j][0] * v[j][0] + v[j][1] * v[j][1]) + (v[j][2] * v[j][2] + v[j][3] * v[j][3]); }
        const float rstd = 1.f / sqrtf(wave_sum(s2) * (1.f / DM) + LN_EPS);
#pragma unroll
        for (int j = 0; j < 8; ++j) ((f32x4*)(F.out + (size_t)t * DM))[lane + 64 * j] = v[j] * rstd * ((const f32x4*)F.in[I_LN2W])[lane + 64 * j] + ((const f32x4*)F.in[I_LN2B])[lane + 64 * j];
    }
}

constexpr int NPHASE = 10;
struct Args { const float* in[28]; float* out; unsigned char* ws; int ph_lo, ph_hi; };
__global__ void __launch_bounds__(512, 2) fwd(Args args) {
    extern __shared__ __attribute__((aligned(16))) unsigned char lds_raw[];
    Frame F;
    F.lds = (LAS unsigned char*)lds_raw;
    F.MISC = (volatile LAS unsigned*)(F.lds + MISC_OFF);
    F.tid = threadIdx.x; F.lane = F.tid & 63; F.wave = __builtin_amdgcn_readfirstlane(F.tid >> 6);
    F.G = gridDim.x; { const int bx = blockIdx.x; F.vcu = (F.G % 8 == 0) ? (bx % 8) * (F.G / 8) + bx / 8 : bx; }
    F.ws = args.ws; F.ctl = (gu32*)(args.ws + WS_CTL); F.out = args.out;
#pragma unroll
    for (int i = 0; i < 28; ++i) F.in[i] = args.in[i];
    for (int u = F.tid; u < 64; u += 512) ((LAS unsigned*)(F.lds + MISC_OFF))[u] = 0u;
    __syncthreads();
    const int lo = args.ph_lo, hi = args.ph_hi;
    const bool use_bar = (hi - lo) > 1;
    XcdBarrier bar; bar.bar = (unsigned*)(F.ctl + CW_BAR); bar.x = 0; bar.st = nullptr;
    if (use_bar) bar = xcd_barrier_post((unsigned*)(F.ctl + CW_BAR), F.MISC + 8);
#ifndef PH_MASK
#define PH_MASK 0x3ff
#endif
#define IN(k) (((PH_MASK >> (k)) & 1) && lo <= (k) && (k) < hi)
#define SEAM(k) do { if (IN(k) && IN((k) + 1)) xcd_barrier(bar); } while (0)

    if (IN(0)) { if (blockIdx.x < 192) p0_adaln(F); p0_convert(F); } SEAM(0);
    if (IN(1)) { p1_ln_mod(F); } SEAM(1);
    if (IN(2)) { InprojOrder S{(int)blockIdx.x, F.G, (const char*)(F.ws + WS_U), (const char*)(F.ws + WS_WINT)}; EpiInprojW E{F.ws, (const f32x2*)(F.ws + WS_ROPE), F.lds + TAB_OFF};
        pg8::gemm_phase<EpiInprojW, InprojOrder, false>(F.lds, DM, S, E);
        GateOrder S2{(int)blockIdx.x, F.G, (const char*)(F.ws + WS_UF8), (const char*)(F.ws + WS_WG8)}; EpiGate E2{(bf16_t*)(F.ws + WS_GNA), (bf16_t*)(F.ws + WS_GDF), F.lds + TAB_OFF};
        pg8::gemm_phase<EpiGate, GateOrder, false, true>(F.lds, DM / 2, S2, E2); } SEAM(2);
    if (IN(3)) { p3_attention(F); } SEAM(3);
    if (IN(4)) { MergeOrder S{(int)blockIdx.x, (const char*)(F.ws + WS_ONA), (const char*)(F.ws + WS_ODF), (const char*)(F.ws + WS_WPNAT), (const char*)(F.ws + WS_WPDFT)};
        EpiMerge E{(const bf16_t*)(F.ws + WS_GNA), (const bf16_t*)(F.ws + WS_GDF), F.ws + WS_YP8, F.lds + TAB_OFF};
        pg8::gemm_phase<EpiMerge, MergeOrder, false>(F.lds, 1024, S, E); } SEAM(4);
    if (IN(5)) { OutOrder S{(int)blockIdx.x, (const char*)(F.ws + WS_YP8), (const char*)(F.ws + WS_WO8)}; EpiOut E{F.in[I_X], (const float*)(F.ws + WS_MOD), (float*)(F.ws + WS_Z)};
        pg8::gemm_phase<EpiOut, OutOrder, false, true>(F.lds, DM / 2, S, E); } SEAM(5);
    if (IN(6)) { p6_router(F); } SEAM(6);
    if (IN(7)) { const MoeTabs tb = moe_tables(F);
        Moe1Order S{(int)blockIdx.x, tb, (const char*)(F.ws + WS_U2F), (const char*)(F.ws + WS_WGUT)};
        { LAS int* tab = (LAS int*)(F.lds + TAB_OFF); const int* tokl = (const int*)(F.ws + WS_TOKL);
          for (int i = 0; i < 10; ++i) { Unit u; if (!S.next(i, u)) break; const int tile = u.row0 >> 8, e = u.tag, r0 = tab[160 + tile] * 256, n = tab[320 + e];
              for (int r = F.tid; r < 256; r += 512) tab[512 + i * 256 + r] = (r0 + r < n) ? tokl[e * NTOK + r0 + r] : 0; }
          __syncthreads(); }
        EpiMoe1 E{F.in[I_BG], F.in[I_BU], F.ws + WS_H};
        pg8::gemm_phase<EpiMoe1, Moe1Order, true, true>(F.lds, DM / 2, S, E); } SEAM(7);
    if (IN(8)) { const MoeTabs tb = moe_tables(F);
        Moe2Order S{(int)blockIdx.x, tb, (const char*)(F.ws + WS_H), (const char*)(F.ws + WS_WDT)}; EpiMoe2 E{F.in[I_BD], (bf16_t*)(F.ws + WS_Y), F.lds + TAB_OFF + 2048};
        pg8::gemm_phase<EpiMoe2, Moe2Order, false, true>(F.lds, DFF / 2, S, E); } SEAM(8);
    if (IN(9)) { (void)moe_tables(F); p9_final(F); }
#undef IN
#undef SEAM
}

extern "C" void kernel_launch(void* const* d_in, const int* in_sizes, int n_in, void* d_out, int out_size, void* d_ws, size_t ws_size, hipStream_t stream) {
    static int grid = 0;
    if (grid == 0) {
        if (n_in != 28 || out_size != NTOK * DM || ws_size < WS_END) { fprintf(stderr, "kernel_launch: unexpected shapes (n_in %d, out %d, ws %zu < %zu)\n", n_in, out_size, ws_size, (size_t)WS_END); grid = -1; return; }
        int dev = 0, cus = 0;
        if (hipGetDevice(&dev) != hipSuccess || hipDeviceGetAttribute(&cus, hipDeviceAttributeMultiprocessorCount, dev) != hipSuccess) { grid = -1; return; }
        if (hipFuncSetAttribute((const void*)fwd, hipFuncAttributeMaxDynamicSharedMemorySize, LDS_BYTES) != hipSuccess) { fprintf(stderr, "kernel_launch: hipFuncSetAttribute failed\n"); grid = -1; return; }
        int per_cu = 0; (void)hipOccupancyMaxActiveBlocksPerMultiprocessor(&per_cu, (const void*)fwd, 512, LDS_BYTES); (void)hipGetLastError();
        if (per_cu < 1) fprintf(stderr, "kernel_launch: occupancy query reports %d\n", per_cu);
        grid = cus < 256 ? cus : 256;
        if (grid != 256) fprintf(stderr, "kernel_launch: %d CUs; this kernel is built for 256\n", cus);
    }
    if (grid < 0) return;
    (void)hipMemsetAsync((char*)d_ws + WS_CTL, 0, CTL_ZERO_BYTES, stream);
    Args a{};
    for (int i = 0; i < 28; ++i) a.in[i] = (const float*)d_in[i];
    a.out = (float*)d_out; a.ws = (unsigned char*)d_ws;
#if MK_SPLIT
#ifndef PROBE_DUP
#define PROBE_DUP -1
#endif
    for (int p = 0; p < NPHASE; ++p) { a.ph_lo = p; a.ph_hi = p + 1; hipLaunchKernelGGL(fwd, dim3(grid), dim3(512), LDS_BYTES, stream, a);
        if (p == PROBE_DUP) hipLaunchKernelGGL(fwd, dim3(grid), dim3(512), LDS_BYTES, stream, a); }
#else
    a.ph_lo = 0; a.ph_hi = NPHASE; hipLaunchKernelGGL(fwd, dim3(grid), dim3(512), LDS_BYTES, stream, a);
#endif
}
```

```cpp
#include <hip/hip_runtime.h>
#include <hip/hip_bf16.h>
#include <cstdio>
#include <cstdint>

#ifndef MK_SPLIT
#define MK_SPLIT 0
#endif

#define GAS __attribute__((address_space(1)))
#define LAS __attribute__((address_space(3)))
typedef unsigned short bf16_t;
typedef short bf16x8 __attribute__((ext_vector_type(8)));
typedef short s16x4 __attribute__((ext_vector_type(4)));
typedef float f32x2 __attribute__((ext_vector_type(2)));
typedef float f32x4 __attribute__((ext_vector_type(4)));
typedef float f32x16 __attribute__((ext_vector_type(16)));
typedef unsigned u32x2 __attribute__((ext_vector_type(2)));
typedef unsigned u32x4 __attribute__((ext_vector_type(4)));
typedef int i32x4 __attribute__((ext_vector_type(4)));
typedef int i32x8 __attribute__((ext_vector_type(8)));
typedef GAS unsigned gu32;
#define RLX_AGENT __ATOMIC_RELAXED, __HIP_MEMORY_SCOPE_AGENT
#define LDS_WAIT() asm volatile("s_waitcnt lgkmcnt(0)" ::: "memory")
#define VM_WAIT() asm volatile("s_waitcnt vmcnt(0)" ::: "memory")

constexpr int DM = 2048, SEQ = 4096, NBATCH = 2, CTXL = 256, RPB = SEQ + CTXL  , MTOT = NBATCH * RPB  , NTOK = NBATCH * SEQ  ;
constexpr int INC = 10240;
constexpr int NH = 8, HD = 128, GRIDW = 64;
constexpr int NEXP = 32, TOPK = 4, DFF = 2048;
constexpr int MAXTILES = 160;
constexpr float LN_EPS = 1e-6f, RMS_EPS = 1e-5f;
constexpr float DN_ALPHA = 1.189207115002721f;
constexpr float LAM_INIT = 0.2f;
constexpr float WSCALE = 64.0f, WSCALE_INV = 1.0f / 64.0f;

constexpr size_t MiB = 1u << 20;
constexpr size_t WS_CTL = 0, CTL_ZERO_BYTES = 1 * MiB;
constexpr size_t WS_MOD = 1 * MiB;
constexpr size_t WS_ROPE = WS_MOD + 256 * 1024;
constexpr size_t WS_ASG_E = 2 * MiB, WS_ASG_P = WS_ASG_E + 128 * 1024, WS_ASG_W = WS_ASG_P + 128 * 1024;
constexpr size_t WS_TOKL = 3 * MiB;
constexpr size_t WS_WINT = 4 * MiB;
constexpr size_t WS_WPNAT = 44 * MiB, WS_WPDFT = 48 * MiB;
constexpr size_t WS_WOT = 52 * MiB;
constexpr size_t WS_WRT = 60 * MiB;
constexpr size_t WS_WGUT = 64 * MiB;
constexpr size_t WS_WDT = 576 * MiB;
constexpr size_t WS_U = 832 * MiB;
constexpr size_t WS_KV = 866 * MiB;
constexpr size_t KV_STRIDE = (size_t)MTOT * 1024 * 2;
constexpr size_t WS_QNA = 934 * MiB, WS_QDF = 950 * MiB;
constexpr size_t WS_GNA = 966 * MiB, WS_GDF = 998 * MiB;
constexpr size_t WS_ONA = 1030 * MiB, WS_ODF = 1046 * MiB;
constexpr size_t WS_O1S = 1062 * MiB;
constexpr size_t WS_T = 1094 * MiB;
constexpr size_t WS_YPRE = 1158 * MiB;
constexpr size_t WS_Z = 1190 * MiB;
constexpr size_t WS_X1 = 1254 * MiB;
constexpr size_t WS_U2H = 1318 * MiB, WS_U2L = 1350 * MiB;
constexpr size_t WS_U2F = 704 * MiB;
constexpr size_t WS_WG8 = 720 * MiB;
constexpr size_t WS_UF8 = 736 * MiB;
constexpr size_t WS_H = 832 * MiB;
constexpr size_t WS_Y = 1094 * MiB;
constexpr size_t WS_END = 1382 * MiB;
static_assert(WS_H + (size_t)MAXTILES * 256 * 2048 * 2 <= WS_ONA, "H overlay");
static_assert(WS_Y + (size_t)MAXTILES * 256 * 2048 * 2 <= WS_X1, "Y overlay");
constexpr int CW_BAR = 4096;
constexpr int CW_CNT = 16384;

constexpr int RING_BYTES = 131072;
constexpr int TAB_OFF = RING_BYTES, TAB_BYTES = 20480;
constexpr int MISC_OFF = TAB_OFF + TAB_BYTES;
constexpr int LDS_BYTES = MISC_OFF + 256;
static_assert(LDS_BYTES <= 160 * 1024, "LDS");

#define XB_TMO      128
#define XB_XCNT(j)  (256  + 64 * (j))
#define XB_XSUB(j)  (1280 + 64 * (j))
#define XB_XGEN(j)  (2304 + 64 * (j))
#define XB_TOP      3328
#define XB_TOPGEN   3392
#define XCD_BAR_WORDS 3456
#define XB_SPIN_CAP (1u << 18)
__device__ __forceinline__ unsigned xb_ld(unsigned* p)              { return __hip_atomic_load(p, __ATOMIC_RELAXED, __HIP_MEMORY_SCOPE_AGENT); }
__device__ __forceinline__ unsigned xb_add(unsigned* p, unsigned v) { return __hip_atomic_fetch_add(p, v, __ATOMIC_RELAXED, __HIP_MEMORY_SCOPE_AGENT); }
__device__ __forceinline__ unsigned xb_xcc_id() { return (unsigned)__builtin_amdgcn_s_getreg((3 << 11) | 20) & 0xFu; }
#define XB_SPIN(cond, bar) do { unsigned _sp = 0; while (cond) { __builtin_amdgcn_s_sleep(1); \
    if ((++_sp & 255u) == 0u) { if (xb_ld(&(bar)[XB_TMO])) break; if (_sp > XB_SPIN_CAP) { atomicAdd(&(bar)[XB_TMO], 1u); break; } } } } while (0)
struct XcdBarrier { unsigned* bar; unsigned x; volatile LAS unsigned* st; };
__device__ __forceinline__ XcdBarrier xcd_barrier_post(unsigned* bar, volatile LAS unsigned* st) {
    XcdBarrier b; b.bar = bar; b.x = xb_xcc_id(); b.st = st;
    if (threadIdx.x == 0) (void)xb_add(&bar[XB_XCNT(b.x)], 1u);
    return b;
}
__device__ __forceinline__ void xcd_barrier_complete(unsigned* bar, unsigned x, unsigned& nloc, unsigned& nx) {
    const unsigned G = gridDim.x * gridDim.y * gridDim.z;
    unsigned sum, cnt, mine, sp = 0u;
    for (;;) {
        sum = 0u; cnt = 0u; mine = 0u;
#pragma unroll
        for (unsigned j = 0; j < 16; ++j) { const unsigned c = xb_ld(&bar[XB_XCNT(j)]); sum += c; cnt += (c > 0u) ? 1u : 0u; mine = (j == x) ? c : mine; }
        if (sum == G) break;
        __builtin_amdgcn_s_sleep(1);
        if ((++sp & 255u) == 0u) { if (xb_ld(&bar[XB_TMO])) break; if (sp > XB_SPIN_CAP) { atomicAdd(&bar[XB_TMO], 1u); break; } }
    }
    nloc = mine > 0u ? mine : 1u; nx = cnt > 0u ? cnt : 1u;
}
__device__ __forceinline__ void xcd_barrier(const XcdBarrier& b) {
    asm volatile("s_waitcnt vmcnt(0)" ::: "memory");
    __syncthreads();
    if (threadIdx.x == 0) {
        unsigned* bar = b.bar;
        __builtin_amdgcn_s_waitcnt(0);
        unsigned nloc = b.st[0], nx = b.st[1];
        if (nloc == 0u) { xcd_barrier_complete(bar, b.x, nloc, nx); b.st[0] = nloc; b.st[1] = nx; }
        const unsigned old = xb_add(&bar[XB_XSUB(b.x)], 1u);
        const unsigned gen = old / nloc;
        if (old + 1u == (gen + 1u) * nloc) {
            __builtin_amdgcn_fence(__ATOMIC_RELEASE, "agent");
            asm volatile("s_waitcnt vmcnt(0)" ::: "memory");
            const unsigned og = xb_add(&bar[XB_TOP], 1u);
            const unsigned tg = og / nx;
            if (og + 1u == (tg + 1u) * nx) xb_add(&bar[XB_TOPGEN], 1u);
            else XB_SPIN(xb_ld(&bar[XB_TOPGEN]) == tg, bar);
            __builtin_amdgcn_fence(__ATOMIC_ACQUIRE, "agent");
            xb_add(&bar[XB_XGEN(b.x)], 1u);
            asm volatile("s_waitcnt vmcnt(0)" ::: "memory");
        } else {
            XB_SPIN(xb_ld(&bar[XB_XGEN(b.x)]) == gen, bar);
            __builtin_amdgcn_fence(__ATOMIC_ACQUIRE, "agent");
            asm volatile("s_waitcnt vmcnt(0)" ::: "memory");
        }
    }
    __syncthreads();
}

__device__ __forceinline__ unsigned cvt_pk_bf16(float lo, float hi) { unsigned r; asm volatile("v_cvt_pk_bf16_f32 %0, %1, %2" : "=v"(r) : "v"(lo), "v"(hi)); return r; }
__device__ __forceinline__ unsigned pk4_fp8(float a, float b, float c, float d) { int w = 0; w = __builtin_amdgcn_cvt_pk_fp8_f32(a, b, w, false); w = __builtin_amdgcn_cvt_pk_fp8_f32(c, d, w, true); return (unsigned)w; }
__device__ __forceinline__ float bf_lo(unsigned w) { return __uint_as_float(w << 16); }
__device__ __forceinline__ float bf_hi(unsigned w) { return __uint_as_float(w & 0xffff0000u); }
__device__ __forceinline__ float wave_sum(float v) {
#pragma unroll
    for (int o = 1; o < 64; o <<= 1) v += __shfl_xor(v, o);
    return v;
}
__device__ __forceinline__ float sigmoidf_fast(float x) { return __builtin_amdgcn_rcpf(1.0f + __builtin_amdgcn_exp2f(-1.4426950408889634f * x)); }

namespace pg8 {
constexpr int BM = 256, BK = 64, HALF = 128, HTB = HALF * BK * 2, STAGE_BYTES = 8 * HTB;
__host__ __device__ __forceinline__ int lds_byte(int r, int c) { const int st = (r >> 4) * 2 + (c >> 5), rr = r & 15, cc = c & 31, ob = rr * 64 + cc * 2; return st * 1024 + (ob ^ (((ob >> 9) & 1) << 5)); }
__host__ __device__ __forceinline__ void stage_rc(int b, int& R, int& C) { const int st = b / 1024, sb = b % 1024, swz = sb ^ (((sb >> 9) & 1) << 5); R = (st >> 1) * 16 + swz / 64; C = (st & 1) * 32 + (swz % 64) / 2; }
__host__ __device__ __forceinline__ int perm32(int rho) { const int n = rho >> 4, i = rho & 15; return 8 * (i >> 2) + 4 * n + (i & 3); }

struct Unit { const char* A; const char* B; int row0, col0, tag, aux; };

template <class E, class = void> struct EpiWide { static constexpr bool value = false; };
template <class E> struct EpiWide<E, decltype((void)E::WIDE)> { static constexpr bool value = E::WIDE; };
template <class E> constexpr bool epi_wide() { return EpiWide<E>::value; }
template <class E, class = void> struct EpiKeep { static __device__ __forceinline__ bool get(const Unit&) { return false; } };
template <class E> struct EpiKeep<E, decltype((void)E::KEEPS)> { static __device__ __forceinline__ bool get(const Unit& u) { return E::keep(u); } };
template <class E> __device__ __forceinline__ bool epi_keep(const Unit& u) { return EpiKeep<E>::get(u); }
template <class Epi, class Sched, bool GATHER, bool F8 = false>
__device__ __forceinline__ void gemm_phase(LAS unsigned char* lds, const int K, const Sched& S, const Epi& E) {
    const int tid = threadIdx.x, wid = __builtin_amdgcn_readfirstlane(tid >> 6), lane = tid & 63, wr = wid >> 2, wc = wid & 3, fr = lane & 15, fq = lane >> 4;
    const int nt = K / BK;
    int RA[2], CA[2];
    unsigned voffB[2], vA[2][2], vN[2][2];
    const size_t kstep = (size_t)(BK * 2);
    const size_t hstep = (size_t)HALF * K * 2;
    const size_t hstepB = epi_wide<Epi>() ? (size_t)32 * K * 2 : hstep;
#pragma unroll
    for (int i = 0; i < 2; ++i) { int R, C; stage_rc(tid * 16 + i * 8192, R, C); const int Rb = epi_wide<Epi>() ? (64 * (R >> 5) + perm32(R & 31)) : (Epi::PERM ? ((R & ~31) + perm32(R & 31)) : R);
        RA[i] = R; CA[i] = C; voffB[i] = (unsigned)(Rb * K + C) * 2u;
        vA[0][i] = (unsigned)(R * K + C) * 2u; vA[1][i] = vA[0][i] + (unsigned)hstep; }
    const unsigned ldsw = (unsigned)wid * 1024u;
    const int aoff = lds_byte(wr * 64 + fr, fq * 8), boff = lds_byte(wc * 32 + fr, fq * 8);
#define PG8_SA(b, h) (((b) * 2 + (h)) * HTB)
#define PG8_SB(b, h) ((4 + (b) * 2 + (h)) * HTB)
#define PG8_STAGE(bufoff, gbase, voff) do { _Pragma("unroll") for (int _i = 0; _i < 2; ++_i) \
        __builtin_amdgcn_global_load_lds((const unsigned*)((const char*)(gbase) + (voff)[_i]), (LAS unsigned*)(lds + (bufoff) + ldsw + _i * 8192), 16, 0, 0); } while (0)
#define PG8_LD32(p) __builtin_shufflevector(*(const LAS i32x4*)(p), *(const LAS i32x4*)((p) + 1024), 0, 1, 2, 3, 4, 5, 6, 7)
#define PG8_LDA(dst, b, h) do { _Pragma("unroll") for (int m = 0; m < 4; ++m) { if constexpr (F8) dst##8[m] = PG8_LD32(lds + PG8_SA(b, h) + aoff + m * 2048); \
        else { _Pragma("unroll") for (int k = 0; k < 2; ++k) dst[m][k] = *(const LAS bf16x8*)(lds + PG8_SA(b, h) + aoff + m * 2048 + k * 1024); } } } while (0)
#define PG8_LDB(dst, b, h) do { _Pragma("unroll") for (int n = 0; n < 2; ++n) { if constexpr (F8) dst##8[n] = PG8_LD32(lds + PG8_SB(b, h) + boff + n * 2048); \
        else { _Pragma("unroll") for (int k = 0; k < 2; ++k) dst[n][k] = *(const LAS bf16x8*)(lds + PG8_SB(b, h) + boff + n * 2048 + k * 1024); } } } while (0)
#define PG8_MMA(ai, bj, At, Bt) do { __builtin_amdgcn_s_setprio(1); _Pragma("unroll") for (int m = 0; m < 4; ++m) _Pragma("unroll") for (int n = 0; n < 2; ++n) { \
        if constexpr (F8) asm volatile("v_mfma_scale_f32_16x16x128_f8f6f4 %0, %1, %2, %0, %3, %3 op_sel_hi:[0,0,0]" : "+v"(acc[ai][bj][m][n]) : "v"(Bt##8[n]), "v"(At##8[m]), "v"(one_scale)); \
        else { _Pragma("unroll") for (int k = 0; k < 2; ++k) acc[ai][bj][m][n] = __builtin_amdgcn_mfma_f32_16x16x32_bf16(Bt[n][k], At[m][k], acc[ai][bj][m][n], 0, 0, 0); } } \
        __builtin_amdgcn_s_setprio(0); } while (0)
#define PG8_WAIT_V(n) asm volatile("s_waitcnt vmcnt(" #n ")" ::: "memory")
#define PG8_WAIT_L(n) asm volatile("s_waitcnt lgkmcnt(" #n ")" ::: "memory")
#define PG8_BAR __builtin_amdgcn_s_barrier()
#define PG8_SCHED __builtin_amdgcn_sched_barrier(0)
    Unit cur, nxt; int ui = 0;
    if (!S.next(0, cur)) return;
    if constexpr (GATHER) { S.offsets(0, RA, CA, vA); }
#pragma unroll
    for (int h = 0; h < 2; ++h)
#pragma unroll
        for (int i = 0; i < 2; ++i) vN[h][i] = vA[h][i];
    f32x4 acc[2][2][4][2];
#pragma unroll
    for (int a = 0; a < 2; ++a)
#pragma unroll
        for (int b = 0; b < 2; ++b)
#pragma unroll
            for (int m = 0; m < 4; ++m)
#pragma unroll
                for (int n = 0; n < 2; ++n) acc[a][b][m][n] = (f32x4){0.f, 0.f, 0.f, 0.f};
    int one_scale = 0x7f7f7f7f; asm volatile("" : "+v"(one_scale));
    bf16x8 At[4][2], B0[2][2], B1[2][2]; i32x8 At8[4], B08[2], B18[2];
    const char* cA = cur.A; const char* cB = cur.B;
    PG8_STAGE(PG8_SB(0, 0), cB, voffB); PG8_STAGE(PG8_SB(0, 1), cB + hstepB, voffB); PG8_STAGE(PG8_SA(0, 0), cA, vA[0]); PG8_STAGE(PG8_SA(0, 1), cA, vA[1]);
    if (wr == 1) PG8_BAR;
    PG8_WAIT_V(2); PG8_BAR;
    PG8_STAGE(PG8_SB(1, 0), cB + kstep, voffB); PG8_STAGE(PG8_SA(1, 0), cA + kstep, vA[0]); PG8_STAGE(PG8_SB(1, 1), cB + hstepB + kstep, voffB);
    PG8_WAIT_V(6); PG8_BAR;
    for (;;) {
        const bool has_next = S.next(ui + 1, nxt);
        const char* nA = has_next ? nxt.A : cA; const char* nB = has_next ? nxt.B : cB;
        for (int t = 0; t < nt; t += 2) {
            const bool last = (t == nt - 2);
            const char* a1 = cA + (size_t)(t + 1) * kstep;
            const char* a2 = last ? nA : cA + (size_t)(t + 2) * kstep; const char* b2 = last ? nB : cB + (size_t)(t + 2) * kstep;
            const char* a3 = a2 + kstep; const char* b3 = b2 + kstep;
            if constexpr (GATHER) { if (last && has_next) S.offsets(ui + 1, RA, CA, vN); }
            PG8_LDB(B0, 0, 0); PG8_LDB(B1, 0, 1); PG8_SCHED; PG8_LDA(At, 0, 0); PG8_STAGE(PG8_SA(1, 1), a1, vA[1]);
            PG8_WAIT_V(8); PG8_WAIT_L(0); PG8_BAR; PG8_MMA(0, 0, At, B0); PG8_MMA(0, 1, At, B1); PG8_BAR; PG8_SCHED;
            PG8_LDA(At, 0, 1); PG8_STAGE(PG8_SB(0, 0), b2, voffB); PG8_STAGE(PG8_SB(0, 1), b2 + hstepB, voffB); PG8_STAGE(PG8_SA(0, 0), a2, vN[0]);
            PG8_WAIT_V(8); PG8_WAIT_L(0); PG8_BAR; PG8_MMA(1, 0, At, B0); PG8_MMA(1, 1, At, B1); PG8_BAR; PG8_SCHED;
            PG8_LDB(B0, 1, 0); PG8_LDB(B1, 1, 1); PG8_SCHED; PG8_LDA(At, 1, 0); PG8_STAGE(PG8_SA(0, 1), a2, vN[1]);
            PG8_WAIT_V(8); PG8_WAIT_L(0); PG8_BAR; PG8_MMA(0, 0, At, B0); PG8_MMA(0, 1, At, B1); PG8_BAR; PG8_SCHED;
            PG8_LDA(At, 1, 1); PG8_STAGE(PG8_SB(1, 0), b3, voffB); PG8_STAGE(PG8_SB(1, 1), b3 + hstepB, voffB); PG8_STAGE(PG8_SA(1, 0), a3, vN[0]);
            PG8_WAIT_V(8); PG8_WAIT_L(0); PG8_BAR; PG8_MMA(1, 0, At, B0); PG8_MMA(1, 1, At, B1); PG8_BAR; PG8_SCHED;
        }
        if (wr == 0) PG8_BAR;
        if constexpr (F8) { asm volatile("s_nop 15\n\ts_nop 15" ::: "memory"); PG8_SCHED; }
        E(acc, cur, wr, wc, fr, fq);
        if (!has_next) break;
        if (!epi_keep<Epi>(cur))
#pragma unroll
        for (int a = 0; a < 2; ++a)
#pragma unroll
            for (int b = 0; b < 2; ++b)
#pragma unroll
                for (int m = 0; m < 4; ++m)
#pragma unroll
                    for (int n = 0; n < 2; ++n) acc[a][b][m][n] = (f32x4){0.f, 0.f, 0.f, 0.f};
        cur = nxt; cA = nA; cB = nB; ++ui;
        if constexpr (GATHER) {
#pragma unroll
            for (int h = 0; h < 2; ++h)
#pragma unroll
                for (int i = 0; i < 2; ++i) vA[h][i] = vN[h][i];
        }
        if (wr == 1) PG8_BAR;
    }
    PG8_WAIT_V(0);
    PG8_BAR;
#undef PG8_SA
#undef PG8_SB
#undef PG8_STAGE
#undef PG8_LDA
#undef PG8_LDB
#undef PG8_MMA
#undef PG8_LD32
#undef PG8_WAIT_V
#undef PG8_WAIT_L
#undef PG8_BAR
#undef PG8_SCHED
}
}

struct Frame {
    LAS unsigned char* lds;
    volatile LAS unsigned* MISC;
    gu32* ctl;
    unsigned char* ws;
    int tid, lane, wave, vcu, G;
    const float* in[28];
    float* out;
};
enum { I_X = 0, I_C, I_CTX, I_CCTX, I_WADA, I_BADA, I_WIN, I_RELB, I_LQ1, I_LK1, I_LQ2, I_LK2, I_SUBLN, I_WPNA, I_WPDF, I_WOUT, I_LN1W, I_LN1B,
       I_WR, I_BR, I_WG, I_BG, I_WU, I_BU, I_WD, I_BD, I_LN2W, I_LN2B };

using pg8::Unit;

struct InprojOrder {
    int c, G; const char* U; const char* W;
    __device__ __forceinline__ bool next(int i, Unit& u) const {
        const int L = i * G + c; if (L >= 800) return false;
        int pmr, pn, lt;
        if (L < 768) {
            const int w = (L % 8) * 96 + L / 8, nig = 8 * 24, gid = w / nig, fm = gid * 8;
            lt = fm + ((w % nig) % 8); pn = (w % nig) / 8; pmr = lt + (lt >= 16 ? 1 : 0);
        } else { const int q = L - 768; pmr = (q & 1) ? 33 : 16; pn = q >> 1; lt = -1; }
        u.A = U + (size_t)pmr * 256 * DM * 2; u.B = W + (size_t)pn * 256 * DM * 2; u.row0 = pmr * 256; u.col0 = pn * 256; u.tag = lt; u.aux = 0;
        return true;
    }
};
struct GateOrder {
    int c, G; const char* UF; const char* W;
    __device__ __forceinline__ bool next(int i, Unit& u) const {
        if (c < 32) return false;
        const int L = i * (G - 32) + (c - 32); if (L >= 512) return false;
        const int lt = L >> 4, pn = L & 15, pmr = lt + (lt >= 16 ? 1 : 0);
        u.A = UF + (size_t)pmr * 256 * DM; u.B = W + (size_t)pn * 256 * DM; u.row0 = lt * 256; u.col0 = pn * 256; u.tag = lt; u.aux = 0; return true;
    }
};
struct EpiGate {
    static constexpr bool PERM = true, WIDE = true;
    bf16_t* GNA; bf16_t* GDF; LAS unsigned char* scr;
    __device__ __forceinline__ void operator()(const f32x4 (&acc)[2][2][4][2], const Unit& u, int wr, int wc, int fr, int fq) const {
        const int lane = threadIdx.x & 63, pn = u.col0 >> 8; LAS unsigned char* my = scr + (threadIdx.x >> 6) * 2304;
        bf16_t* base = (pn < 8 ? GNA : GDF) + (pn & 7) * 256 + wc * 64 + 8 * (lane & 7);
#pragma unroll
        for (int ai = 0; ai < 2; ++ai)
#pragma unroll
            for (int m = 0; m < 4; ++m) {
#pragma unroll
                for (int bj = 0; bj < 2; ++bj) { const f32x4 v0 = acc[ai][bj][m][0] * WSCALE_INV, v1 = acc[ai][bj][m][1] * WSCALE_INV;
                    u32x4 w; w.x = cvt_pk_bf16(v0[0], v0[1]); w.y = cvt_pk_bf16(v0[2], v0[3]); w.z = cvt_pk_bf16(v1[0], v1[1]); w.w = cvt_pk_bf16(v1[2], v1[3]);
                    *(LAS u32x4*)(my + fr * 144 + bj * 64 + fq * 16) = w; }
#pragma unroll
                for (int hh = 0; hh < 2; ++hh) { const int row = (lane >> 3) + 8 * hh; const u32x4 x = *(const LAS u32x4*)(my + row * 144 + (lane & 7) * 16);
                    *(u32x4*)(base + (size_t)(u.row0 + ai * 128 + wr * 64 + m * 16 + row) * DM) = x; }
            }
    }
};
struct EpiInproj {
    static constexpr bool PERM = true;
    unsigned char* ws; const f32x2* rope; int nostore;
    __device__ __forceinline__ void operator()(const f32x4 (&acc)[2][2][4][2], const Unit& u, int wr, int wc, int fr, int fq) const {
        const int pn = u.col0 >> 8, t = pn >> 2, lt = u.tag;
        bf16_t* base; int ldc, colt, rowb;
        if (t < 4) { base = (bf16_t*)(ws + WS_KV + (size_t)t * KV_STRIDE); ldc = 1024; colt = (pn & 3) * 256; rowb = u.row0; }
        else if (t == 4) { base = (bf16_t*)(ws + WS_QNA); ldc = 1024; colt = (pn & 3) * 256; rowb = lt * 256; }
        else if (t == 5) { base = (bf16_t*)(ws + WS_QDF); ldc = 1024; colt = (pn & 3) * 256; rowb = lt * 256; }
        else if (t < 8) { base = (bf16_t*)(ws + WS_GNA); ldc = 2048; colt = (pn - 24) * 256; rowb = lt * 256; }
        else { base = (bf16_t*)(ws + WS_GDF); ldc = 2048; colt = (pn - 32) * 256; rowb = lt * 256; }
        const bool do_rope = (lt >= 0) && (t == 2 || t == 5);
        const int col0 = colt + wc * 32 + 8 * fq;
#pragma unroll
        for (int ai = 0; ai < 2; ++ai)
#pragma unroll
            for (int m = 0; m < 4; ++m) {
                const int rl = ai * 128 + wr * 64 + m * 16 + fr;
                bf16_t* rowp = base + (size_t)(rowb + rl) * ldc + col0;
                const int s = (lt * 256 + rl) & 4095, rpos = s >> 6, cpos = s & 63;
#pragma unroll
                for (int bj = 0; bj < 2; ++bj) {
                    f32x4 v0 = acc[ai][bj][m][0], v1 = acc[ai][bj][m][1];
                    if (do_rope) {
                        const int pos = ((bj * 4 + wc) & 1) ? cpos : rpos;
                        const f32x4* cs = (const f32x4*)(rope + pos * 16 + 4 * fq);
                        const f32x4 c01 = cs[0], c23 = cs[1];
                        const float cc[4] = {c01[0], c01[2], c23[0], c23[2]}, sn[4] = {c01[1], c01[3], c23[1], c23[3]};
                        f32x4 o0, o1;
#pragma unroll
                        for (int e = 0; e < 4; ++e) { o0[e] = v0[e] * cc[e] - v1[e] * sn[e]; o1[e] = v1[e] * cc[e] + v0[e] * sn[e]; }
                        v0 = o0; v1 = o1;
                    }
                    u32x4 w; w.x = cvt_pk_bf16(v0[0], v0[1]); w.y = cvt_pk_bf16(v0[2], v0[3]); w.z = cvt_pk_bf16(v1[0], v1[1]); w.w = cvt_pk_bf16(v1[2], v1[3]);
                    if (!nostore || w.x == 0x12345678u) *(u32x4*)(rowp + bj * 128) = w;
                }
            }
    }
};

struct EpiInprojW {
    static constexpr bool PERM = true, WIDE = true;
    unsigned char* ws; const f32x2* rope; LAS unsigned char* scr;
    __device__ __forceinline__ void operator()(const f32x4 (&acc)[2][2][4][2], const Unit& u, int wr, int wc, int fr, int fq) const {
        const int pn = u.col0 >> 8, t = pn >> 2, lt = u.tag, lane = threadIdx.x & 63;
        LAS unsigned char* my = scr + (threadIdx.x >> 6) * 2304;
        bf16_t* base; int ldc, colt, rowb;
        if (t < 4) { base = (bf16_t*)(ws + WS_KV + (size_t)t * KV_STRIDE); ldc = 1024; colt = (pn & 3) * 256; rowb = u.row0; }
        else if (t == 4) { base = (bf16_t*)(ws + WS_QNA); ldc = 1024; colt = (pn & 3) * 256; rowb = lt * 256; }
        else if (t == 5) { base = (bf16_t*)(ws + WS_QDF); ldc = 1024; colt = (pn & 3) * 256; rowb = lt * 256; }
        else if (t < 8) { base = (bf16_t*)(ws + WS_GNA); ldc = 2048; colt = (pn - 24) * 256; rowb = lt * 256; }
        else { base = (bf16_t*)(ws + WS_GDF); ldc = 2048; colt = (pn - 32) * 256; rowb = lt * 256; }
        const bool do_rope = (lt >= 0) && (t == 2 || t == 5);
        const int colw = colt + wc * 64 + 8 * (lane & 7);
#pragma unroll
        for (int ai = 0; ai < 2; ++ai)
#pragma unroll
            for (int m = 0; m < 4; ++m) {
                const int rl = ai * 128 + wr * 64 + m * 16 + fr;
                const int s = (lt * 256 + rl) & 4095, rpos = s >> 6, cpos = s & 63;
#pragma unroll
                for (int bj = 0; bj < 2; ++bj) {
                    f32x4 v0 = acc[ai][bj][m][0], v1 = acc[ai][bj][m][1];
                    if (do_rope) {
                        const int pos = bj ? cpos : rpos;
                        const f32x4* cs = (const f32x4*)(rope + pos * 16 + 4 * fq);
                        const f32x4 c01 = cs[0], c23 = cs[1];
                        const float cc[4] = {c01[0], c01[2], c23[0], c23[2]}, sn[4] = {c01[1], c01[3], c23[1], c23[3]};
                        f32x4 o0, o1;
#pragma unroll
                        for (int e = 0; e < 4; ++e) { o0[e] = v0[e] * cc[e] - v1[e] * sn[e]; o1[e] = v1[e] * cc[e] + v0[e] * sn[e]; }
                        v0 = o0; v1 = o1;
                    }
                    u32x4 w; w.x = cvt_pk_bf16(v0[0], v0[1]); w.y = cvt_pk_bf16(v0[2], v0[3]); w.z = cvt_pk_bf16(v1[0], v1[1]); w.w = cvt_pk_bf16(v1[2], v1[3]);
                    *(LAS u32x4*)(my + fr * 144 + bj * 64 + fq * 16) = w;
                }
#pragma unroll
                for (int hh = 0; hh < 2; ++hh) { const int row = (lane >> 3) + 8 * hh; const u32x4 x = *(const LAS u32x4*)(my + row * 144 + (lane & 7) * 16);
                    *(u32x4*)(base + (size_t)(rowb + ai * 128 + wr * 64 + m * 16 + row) * ldc + colw) = x; }
            }
    }
};

__device__ __forceinline__ void static_tile(int L, int nM, int nN, int& pm, int& pn) {
    const int nwg = nM * nN, q = nwg / 8, r = nwg % 8, xcd = L % 8, off = L / 8;
    const int w = (xcd < r ? xcd * (q + 1) : r * (q + 1) + (xcd - r) * q) + off;
    const int nig = 8 * nN, gid = w / nig, fm = gid * 8, gsz = (nM - fm) < 8 ? (nM - fm) : 8;
    pm = fm + ((w % nig) % gsz); pn = (w % nig) / gsz;
}

struct MergeOrder {
    int c; const char* ONA; const char* ODF; const char* WNA; const char* WDF;
    __device__ __forceinline__ bool next(int i, Unit& u) const {
        if (i >= 2 || c >= 256) return false;
        int pm, pn; static_tile(c, 32, 8, pm, pn);
        u.A = (i == 0 ? ONA : ODF) + (size_t)pm * 256 * 1024 * 2; u.B = (i == 0 ? WNA : WDF) + (size_t)pn * 256 * 1024 * 2;
        u.row0 = pm * 256; u.col0 = pn * 256; u.tag = i; u.aux = 0; return true;
    }
};
struct EpiMerge {
    static constexpr bool PERM = true, WIDE = true, KEEPS = true;
    static __device__ __forceinline__ bool keep(const Unit& u) { return u.tag == 0; }
    const bf16_t* GNA; const bf16_t* GDF; bf16_t* YPRE; LAS unsigned char* scr;
    __device__ __forceinline__ void operator()(f32x4 (&acc)[2][2][4][2], const Unit& u, int wr, int wc, int fr, int fq) const {
        const int lane = threadIdx.x & 63; LAS unsigned char* my = scr + (threadIdx.x >> 6) * 2304;
        const int col0 = u.col0 + wc * 64 + 8 * fq, colw = u.col0 + wc * 64 + 8 * (lane & 7);
#pragma unroll
        for (int ai = 0; ai < 2; ++ai)
#pragma unroll
            for (int m = 0; m < 4; ++m) {
                const size_t ro = (size_t)(u.row0 + ai * 128 + wr * 64 + m * 16 + fr) * DM + col0;
#pragma unroll
                for (int bj = 0; bj < 2; ++bj) {
                    const u32x4 gd = *(const u32x4*)(GDF + ro + bj * 32);
                    const float ed[8] = {bf_lo(gd.x), bf_hi(gd.x), bf_lo(gd.y), bf_hi(gd.y), bf_lo(gd.z), bf_hi(gd.z), bf_lo(gd.w), bf_hi(gd.w)};
                    if (u.tag == 0) {
                        const u32x4 gn = *(const u32x4*)(GNA + ro + bj * 32);
                        const float en[8] = {bf_lo(gn.x), bf_hi(gn.x), bf_lo(gn.y), bf_hi(gn.y), bf_lo(gn.z), bf_hi(gn.z), bf_lo(gn.w), bf_hi(gn.w)};
#pragma unroll
                        for (int e = 0; e < 8; ++e) {
                            const float r = (1.0f + __builtin_amdgcn_exp2f(-1.4426950408889634f * ed[e])) * __builtin_amdgcn_rcpf(1.0f + __builtin_amdgcn_exp2f(-1.4426950408889634f * en[e]));
                            acc[ai][bj][m][e >> 2][e & 3] *= r; }
                    } else {
                        float y[8];
#pragma unroll
                        for (int e = 0; e < 8; ++e) y[e] = acc[ai][bj][m][e >> 2][e & 3] * sigmoidf_fast(ed[e]);
                        u32x4 w; w.x = cvt_pk_bf16(y[0], y[1]); w.y = cvt_pk_bf16(y[2], y[3]); w.z = cvt_pk_bf16(y[4], y[5]); w.w = cvt_pk_bf16(y[6], y[7]);
                        *(LAS u32x4*)(my + fr * 144 + bj * 64 + fq * 16) = w;
                    }
                }
                if (u.tag != 0) {
#pragma unroll
                    for (int hh = 0; hh < 2; ++hh) { const int row = (lane >> 3) + 8 * hh; const u32x4 x = *(const LAS u32x4*)(my + row * 144 + (lane & 7) * 16);
                        *(u32x4*)(YPRE + (size_t)(u.row0 + ai * 128 + wr * 64 + m * 16 + row) * DM + colw) = x; }
                }
            }
    }
};

struct OutOrder {
    int c; const char* A; const char* B;
    __device__ __forceinline__ bool next(int i, Unit& u) const {
        if (i >= 1 || c >= 256) return false;
        int pm, pn; static_tile(c, 32, 8, pm, pn);
        u.A = A + (size_t)pm * 256 * DM * 2; u.B = B + (size_t)pn * 256 * DM * 2; u.row0 = pm * 256; u.col0 = pn * 256; u.tag = 0; u.aux = 0; return true;
    }
};
struct EpiOut {
    static constexpr bool PERM = true, WIDE = true;
    const float* x; const float* mod; bf16_t* ZB; LAS unsigned char* scr;
    __device__ __forceinline__ void operator()(const f32x4 (&acc)[2][2][4][2], const Unit& u, int wr, int wc, int fr, int fq) const {
        const int lane = threadIdx.x & 63, b = u.row0 >> 12; LAS unsigned char* my = scr + (threadIdx.x >> 6) * 2304;
        const int col0 = u.col0 + wc * 64 + 8 * fq, colw = u.col0 + wc * 64 + 8 * (lane & 7);
        const float* gm = mod + (size_t)b * 12288 + 4096 + col0;
        f32x4 gv[2][2];
#pragma unroll
        for (int bj = 0; bj < 2; ++bj)
#pragma unroll
            for (int n = 0; n < 2; ++n) gv[bj][n] = *(const f32x4*)(gm + bj * 32 + 4 * n);
#pragma unroll
        for (int ai = 0; ai < 2; ++ai)
#pragma unroll
            for (int m = 0; m < 4; ++m) {
                const float* xr = x + (size_t)(u.row0 + ai * 128 + wr * 64 + m * 16 + fr) * DM + col0;
#pragma unroll
                for (int bj = 0; bj < 2; ++bj) { const f32x4 x0 = *(const f32x4*)(xr + bj * 32), x1 = *(const f32x4*)(xr + bj * 32 + 4);
                    const f32x4 v0 = x0 * DN_ALPHA + gv[bj][0] * acc[ai][bj][m][0], v1 = x1 * DN_ALPHA + gv[bj][1] * acc[ai][bj][m][1];
                    u32x4 w; w.x = cvt_pk_bf16(v0[0], v0[1]); w.y = cvt_pk_bf16(v0[2], v0[3]); w.z = cvt_pk_bf16(v1[0], v1[1]); w.w = cvt_pk_bf16(v1[2], v1[3]);
                    *(LAS u32x4*)(my + fr * 144 + bj * 64 + fq * 16) = w; }
#pragma unroll
                for (int hh = 0; hh < 2; ++hh) { const int row = (lane >> 3) + 8 * hh; const u32x4 xx = *(const LAS u32x4*)(my + row * 144 + (lane & 7) * 16);
                    *(u32x4*)(ZB + (size_t)(u.row0 + ai * 128 + wr * 64 + m * 16 + row) * DM + colw) = xx; }
            }
    }
};

struct MoeTabs { const LAS int* tile_e; const LAS int* tile_r; const LAS int* tokl; int ntiles; };
struct Moe1Order {
    int c; MoeTabs tb; const char* U2; const char* W;
    __device__ __forceinline__ bool next(int i, Unit& u) const {
        const int x = c & 7, j = c >> 3, tile = 16 * i + 4 * (x >> 1) + (j & 3), nb = 8 * (x & 1) + (j >> 2);
        if (tile >= tb.ntiles) return false;
        const int e = tb.tile_e[tile];
        u.A = U2; u.B = W + ((size_t)(e * 16 + nb) * 256) * DM; u.row0 = tile * 256; u.col0 = nb * 128; u.tag = e; u.aux = i; return true;
    }
    __device__ __forceinline__ void offsets(int i, const int (&RA)[2], const int (&CA)[2], unsigned (&v)[2][2]) const {
#pragma unroll
        for (int h = 0; h < 2; ++h)
#pragma unroll
            for (int k = 0; k < 2; ++k) { const int tok = tb.tokl[i * 256 + RA[k] + 128 * h]; v[h][k] = (unsigned)(tok * (DM / 2) + CA[k]) * 2u; }
    }
};
struct EpiMoe1 {
    static constexpr bool PERM = true;
    const float* bg; const float* bu; unsigned char* H;
    __device__ __forceinline__ void operator()(const f32x4 (&acc)[2][2][4][2], const Unit& u, int wr, int wc, int fr, int fq) const {
        const int col0 = u.col0 + wc * 32 + 8 * fq;
        const float* pg = bg + (size_t)u.tag * DFF + col0; const float* pu = bu + (size_t)u.tag * DFF + col0;
        const f32x4 g0 = *(const f32x4*)pg, g1 = *(const f32x4*)(pg + 4), u0 = *(const f32x4*)pu, u1 = *(const f32x4*)(pu + 4);
#pragma unroll
        for (int ai = 0; ai < 2; ++ai)
#pragma unroll
            for (int m = 0; m < 4; ++m) {
                unsigned char* rowp = H + (size_t)(u.row0 + ai * 128 + wr * 64 + m * 16 + fr) * DFF + col0;
                float hv[8];
#pragma unroll
                for (int n = 0; n < 2; ++n)
#pragma unroll
                    for (int e = 0; e < 4; ++e) {
                        const float g = fminf(acc[ai][0][m][n][e] * WSCALE_INV + (n ? g1[e] : g0[e]), 7.0f);
                        const float l = fminf(fmaxf(acc[ai][1][m][n][e] * WSCALE_INV + (n ? u1[e] : u0[e]), -7.0f), 7.0f);
                        hv[n * 4 + e] = g * sigmoidf_fast(1.702f * g) * (l + 1.0f);
                    }
                u32x2 w; w.x = pk4_fp8(hv[0], hv[1], hv[2], hv[3]); w.y = pk4_fp8(hv[4], hv[5], hv[6], hv[7]);
                *(u32x2*)rowp = w;
            }
    }
};
struct Moe2Order {
    int c; MoeTabs tb; const char* H; const char* W;
    __device__ __forceinline__ bool next(int i, Unit& u) const {
        const int x = c & 7, j = c >> 3, tile = 32 * i + 4 * x + (j & 3), pn = j >> 2;
        if (tile >= tb.ntiles) return false;
        const int e = tb.tile_e[tile];
        u.A = H + (size_t)tile * 256 * DFF; u.B = W + ((size_t)e * DM + pn * 256) * DFF; u.row0 = tile * 256; u.col0 = pn * 256; u.tag = e; u.aux = 0; return true;
    }
};
struct EpiMoe2 {
    static constexpr bool PERM = true, WIDE = true;
    const float* bd; bf16_t* Y; LAS unsigned char* scr;
    __device__ __forceinline__ void operator()(const f32x4 (&acc)[2][2][4][2], const Unit& u, int wr, int wc, int fr, int fq) const {
        const int lane = threadIdx.x & 63; LAS unsigned char* my = scr + (threadIdx.x >> 6) * 2304;
        const float* pb = bd + (size_t)u.tag * DM + u.col0 + wc * 64 + 8 * fq;
        f32x4 bv[2][2];
#pragma unroll
        for (int bj = 0; bj < 2; ++bj)
#pragma unroll
            for (int n = 0; n < 2; ++n) bv[bj][n] = *(const f32x4*)(pb + bj * 32 + 4 * n);
        const int colw = u.col0 + wc * 64 + 8 * (lane & 7);
#pragma unroll
        for (int ai = 0; ai < 2; ++ai)
#pragma unroll
            for (int m = 0; m < 4; ++m) {
#pragma unroll
                for (int bj = 0; bj < 2; ++bj) { const f32x4 v0 = acc[ai][bj][m][0] * WSCALE_INV + bv[bj][0], v1 = acc[ai][bj][m][1] * WSCALE_INV + bv[bj][1];
                    u32x4 w; w.x = cvt_pk_bf16(v0[0], v0[1]); w.y = cvt_pk_bf16(v0[2], v0[3]); w.z = cvt_pk_bf16(v1[0], v1[1]); w.w = cvt_pk_bf16(v1[2], v1[3]);
                    *(LAS u32x4*)(my + fr * 144 + bj * 64 + fq * 16) = w; }
#pragma unroll
                for (int hh = 0; hh < 2; ++hh) { const int row = (lane >> 3) + 8 * hh; const u32x4 x = *(const LAS u32x4*)(my + row * 144 + (lane & 7) * 16);
                    *(u32x4*)(Y + (size_t)(u.row0 + ai * 128 + wr * 64 + m * 16 + row) * DM + colw) = x; }
            }
    }
};

namespace attn {
constexpr int NW = 8, QBLK = 32, KVBLK = 64, LDK = 1024;
constexpr int SHM_V = KVBLK * 128 * 2, SHM_K = KVBLK * 128 * 2;
constexpr int OFF_V = 0, OFF_K = 2 * SHM_V, OFF_WS = 2 * SHM_V + 2 * SHM_K, OFF_BIAS = OFF_WS + NW * 64 * 4, OFF_Q = OFF_BIAS + 4096, ATTN_LDS = OFF_Q + 65536;
constexpr float THR = 8.f;
#define KSWZ(row, colB) ((row) * 256 + ((colB) ^ (((row) & 7) << 4)))
#define SBAR() __builtin_amdgcn_sched_barrier(0)
__device__ __forceinline__ int crow(int r, int hi) { return (r & 3) + 8 * (r >> 2) + 4 * hi; }
template <int MODE> struct Cfg { static constexpr float SCALE = MODE == 0 ? 0.08838834764831845f : 0.125f; static constexpr int ND = MODE == 0 ? 8 : 4; };

template <int MODE>
__device__ __forceinline__ void partialSM(f32x16& p0, f32x16& p1, float& m_reg, float& mn, float& alpha) {
    constexpr float SCALE = Cfg<MODE>::SCALE, C = SCALE * 1.4426950408889634f;
    float pmax = p0[0];
#pragma unroll
    for (int r = 1; r < 16; ++r) pmax = fmaxf(pmax, p0[r]);
#pragma unroll
    for (int r = 0; r < 16; ++r) pmax = fmaxf(pmax, p1[r]);
    { auto rr = __builtin_amdgcn_permlane32_swap(__float_as_uint(pmax), __float_as_uint(pmax), false, false);
      pmax = fmaxf(__uint_as_float(rr[0]), __uint_as_float(rr[1])); }
    if (__builtin_expect(__all(pmax - m_reg <= THR / SCALE), 1)) { mn = m_reg; alpha = 1.f; }
    else { mn = fmaxf(m_reg, pmax); alpha = __builtin_amdgcn_exp2f((m_reg - mn) * C); m_reg = mn; }
    const float mnC = -mn * C;
#pragma unroll
    for (int r = 0; r < 16; ++r) p0[r] = fmaf(p0[r], C, mnC);
#pragma unroll
    for (int r = 0; r < 16; ++r) p1[r] = fmaf(p1[r], C, mnC);
#pragma unroll
    for (int r = 0; r < 16; ++r) p0[r] = __builtin_amdgcn_exp2f(p0[r]);
}
__device__ __forceinline__ void finishSM(f32x16& p0, f32x16& p1, float alpha, float& l_reg, bf16x8& pa0, bf16x8& pa1, bf16x8& pa2, bf16x8& pa3) {
#pragma unroll
    for (int r = 0; r < 16; ++r) p1[r] = __builtin_amdgcn_exp2f(p1[r]);
    float ps = 0;
#pragma unroll
    for (int r = 0; r < 16; ++r) ps += p0[r];
#pragma unroll
    for (int r = 0; r < 16; ++r) ps += p1[r];
    { auto rr = __builtin_amdgcn_permlane32_swap(__float_as_uint(ps), __float_as_uint(ps), false, false);
      ps = __uint_as_float(rr[0]) + __uint_as_float(rr[1]); }
    l_reg = l_reg * alpha + ps;
#define PK4(P, BASE, OUT) do { unsigned a0 = cvt_pk_bf16(P[BASE + 0], P[BASE + 1]), a1 = cvt_pk_bf16(P[BASE + 2], P[BASE + 3]);   \
    unsigned b0 = cvt_pk_bf16(P[BASE + 4], P[BASE + 5]), b1 = cvt_pk_bf16(P[BASE + 6], P[BASE + 7]);                              \
    auto r0 = __builtin_amdgcn_permlane32_swap(a0, b0, false, false); auto r1 = __builtin_amdgcn_permlane32_swap(a1, b1, false, false); \
    u32x4 w = {r0[0], r1[0], r0[1], r1[1]}; OUT = *reinterpret_cast<bf16x8*>(&w); } while (0)
    PK4(p0, 0, pa0); PK4(p0, 8, pa1); PK4(p1, 0, pa2); PK4(p1, 8, pa3);
#undef PK4
}
template <int MODE>
__device__ __forceinline__ void qkt(f32x16& p0, f32x16& p1, const LAS unsigned char* Ks, const bf16x8* qr, const LAS unsigned char* Qs, int r32, int hi, int cbase) {
    p0 = f32x16{}; p1 = f32x16{};
#pragma unroll
    for (int d0 = 0; d0 < Cfg<MODE>::ND; ++d0) { const int cb = cbase + (d0 * 16 + hi * 8) * 2;
        const bf16x8 b0 = *(const LAS bf16x8*)(Ks + KSWZ(r32, cb));
        const bf16x8 b1 = *(const LAS bf16x8*)(Ks + KSWZ(32 + r32, cb));
        bf16x8 q; if constexpr (MODE == 0) q = *(const LAS bf16x8*)(Qs + KSWZ(r32, cb)); else q = qr[d0];
        p0 = __builtin_amdgcn_mfma_f32_32x32x16_bf16(b0, q, p0, 0, 0, 0);
        p1 = __builtin_amdgcn_mfma_f32_32x32x16_bf16(b1, q, p1, 0, 0, 0); }
}
__device__ __forceinline__ int v_st(int k, int c) { const int kk = (k & ~0xC) | ((k & 4) << 1) | ((k & 8) >> 1); return ((kk >> 3) * 4 + (c >> 5)) * 512 + ((kk & 7) * 32 + (c & 31)) * 2; }
__device__ __forceinline__ int v_rd_base(int lane) { return ((lane & 3) << 3) | (((lane >> 2) & 3) << 6) | (((lane >> 4) & 1) << 5) | (((lane >> 5) & 1) << 8); }
constexpr int v_rd_off(int d0, int ks, int half) { return d0 * 512 + ks * 4096 + half * 2048; }
template <int OFF> __device__ __forceinline__ s16x4 tr_read(int vb) {
    s16x4 r; asm volatile("ds_read_b64_tr_b16 %0, %1 offset:%2" : "=&v"(r) : "v"(vb), "i"(OFF) : "memory"); return r;
}
template <int D0> __device__ __forceinline__ void pv_one(f32x16& od, int vb, bf16x8 pa0, bf16x8 pa1, bf16x8 pa2, bf16x8 pa3) {
    const s16x4 l0 = tr_read<v_rd_off(D0, 0, 0)>(vb), h0 = tr_read<v_rd_off(D0, 0, 1)>(vb), l1 = tr_read<v_rd_off(D0, 1, 0)>(vb), h1 = tr_read<v_rd_off(D0, 1, 1)>(vb);
    const s16x4 l2 = tr_read<v_rd_off(D0, 2, 0)>(vb), h2 = tr_read<v_rd_off(D0, 2, 1)>(vb), l3 = tr_read<v_rd_off(D0, 3, 0)>(vb), h3 = tr_read<v_rd_off(D0, 3, 1)>(vb);
    asm volatile("s_waitcnt lgkmcnt(0)" ::: "memory"); SBAR();
#define PKV(L, H) (bf16x8){L[0], L[1], L[2], L[3], H[0], H[1], H[2], H[3]}
    od = __builtin_amdgcn_mfma_f32_32x32x16_bf16(pa0, PKV(l0, h0), od, 0, 0, 0);
    od = __builtin_amdgcn_mfma_f32_32x32x16_bf16(pa1, PKV(l1, h1), od, 0, 0, 0);
    od = __builtin_amdgcn_mfma_f32_32x32x16_bf16(pa2, PKV(l2, h2), od, 0, 0, 0);
    od = __builtin_amdgcn_mfma_f32_32x32x16_bf16(pa3, PKV(l3, h3), od, 0, 0, 0);
#undef PKV
}
__device__ __forceinline__ void pv_d0(f32x16* o, int vb, bf16x8 pa0, bf16x8 pa1, bf16x8 pa2, bf16x8 pa3) {
    pv_one<0>(o[0], vb, pa0, pa1, pa2, pa3); pv_one<1>(o[1], vb, pa0, pa1, pa2, pa3); pv_one<2>(o[2], vb, pa0, pa1, pa2, pa3); pv_one<3>(o[3], vb, pa0, pa1, pa2, pa3);
}
__device__ __forceinline__ void na_mask(f32x16& p0, f32x16& p1, bool rowvalid, const LAS float* bp, int tv) {
    asm volatile("" : "+v"(tv));
    if (!rowvalid) {
#pragma unroll
        for (int r = 0; r < 16; ++r) { p0[r] = -1e30f; p1[r] = -1e30f; }
        return;
    }
#pragma unroll
    for (int r = 0; r < 16; ++r) {
        const int c0 = (r & 3) + 8 * (r >> 2);
        float b0 = bp[c0], b1 = bp[c0 + 32];
        asm volatile("" : "+v"(b0), "+v"(b1));
        const float t0 = p0[r] + b0, t1 = p1[r] + b1;
        p0[r] = ((unsigned)(c0 + tv) < 16u) ? t0 : -1e30f;
        p1[r] = ((unsigned)(c0 + 32 + tv) < 16u) ? t1 : -1e30f;
    }
}

template <int MODE>
__device__ __forceinline__ void attn_pass(const bf16_t* __restrict__ Qb, const bf16_t* __restrict__ Kh, const bf16_t* __restrict__ Vh, const int NT, const int kr0, const int g4, const int map,
                                          LAS unsigned char* lds, f32x16 (&o)[4]) {
    constexpr int ND = Cfg<MODE>::ND;
    const int tid = threadIdx.x, wid = tid >> 6, lane = tid & 63, r32 = lane & 31, hi = lane >> 5;
    LAS unsigned char* V_lds = lds + OFF_V; LAS unsigned char* K_lds = lds + OFF_K;
    LAS float* ws = (LAS float*)(lds + OFF_WS) + wid * 64; LAS float* li_l = ws; LAS float* al_l = ws + 32;
    const LAS float* biasL = (const LAS float*)(lds + OFF_BIAS);
    float m_reg = -1e30f, l_reg = 0;
#pragma unroll
    for (int d = 0; d < 4; ++d) o[d] = f32x16{};
    bf16x8 qr[ND];
    const bf16_t* Qw = Qb + (long)(wid * QBLK + r32) * LDK + hi * 8;
    LAS unsigned char* Qs = lds + OFF_Q + wid * (QBLK * 256);
#pragma unroll
    for (int d0 = 0; d0 < ND; ++d0) { qr[d0] = *(const bf16x8*)(Qw + d0 * 16); if constexpr (MODE == 0) *(LAS bf16x8*)(Qs + KSWZ(r32, (d0 * 16 + hi * 8) * 2)) = qr[d0]; }
    const int cbase = MODE == 1 ? map * 128 : 0;
    const int sr = tid >> 4, sc = (tid & 15) * 8, vst0 = v_st(sr, sc), vst1 = v_st(32 + sr, sc);
    const int vb0 = (int)(uintptr_t)V_lds + v_rd_base(lane);
    const int qR = g4 * 4 + (wid >> 1), qc = 32 * (wid & 1) + r32, cs = qc < 8 ? 0 : (qc > 56 ? 48 : qc - 8);
    const int r0w = qR < 4 ? 0 : (qR > 60 ? 56 : qR - 4);
    struct { bf16x8 vs0, vs1, ks0, ks1; } sr_[2];
#define TROW(jt) (MODE == 0 ? ((jt) < 4 ? SEQ + 64 * (jt) : (kr0 + (jt) - 4) * 64) : 64 * (jt))
#define SLOAD(i, jt) do { const long k0_ = TROW(jt); sr_[i].vs0 = *(const bf16x8*)(&Vh[(k0_ + sr) * LDK + sc]); sr_[i].vs1 = *(const bf16x8*)(&Vh[(k0_ + 32 + sr) * LDK + sc]); \
    sr_[i].ks0 = *(const bf16x8*)(&Kh[(k0_ + sr) * LDK + sc]); sr_[i].ks1 = *(const bf16x8*)(&Kh[(k0_ + 32 + sr) * LDK + sc]); } while (0)
#define SWRITE(b, i) do { *(LAS bf16x8*)(V_lds + (b) * SHM_V + vst0) = sr_[i].vs0; *(LAS bf16x8*)(V_lds + (b) * SHM_V + vst1) = sr_[i].vs1; const int kc_ = sc * 2; \
    *(LAS bf16x8*)(K_lds + (b) * SHM_K + KSWZ(sr, kc_)) = sr_[i].ks0; *(LAS bf16x8*)(K_lds + (b) * SHM_K + KSWZ(32 + sr, kc_)) = sr_[i].ks1; } while (0)
#define SWAIT() asm volatile("s_waitcnt vmcnt(4)" ::: "memory")
#define RESC(a) do { if (__any((a) < 1.f)) { if (hi == 0) al_l[r32] = (a); asm volatile("s_waitcnt lgkmcnt(0)" ::: "memory"); \
    _Pragma("unroll") for (int d = 0; d < 4; ++d) _Pragma("unroll") for (int r = 0; r < 16; ++r) o[d][r] *= al_l[crow(r, hi)]; } } while (0)
#define MASK(P0, P1, jt) do { if (MODE == 0 && (jt) >= 4) { const int kr_ = kr0 + (jt) - 4; const bool rv_ = (kr_ >= r0w) && (kr_ < r0w + 8); int br_ = kr_ - qR + 7; br_ = br_ < 0 ? 0 : (br_ > 14 ? 14 : br_); \
    na_mask(P0, P1, rv_, biasL + 64 + br_ * 32 + (4 * hi - qc + 15), 4 * hi - cs); } } while (0)
    f32x16 pA0, pA1, pB0, pB1; float mnA, mnB, alA, alB; bf16x8 pa0, pa1, pa2, pa3;
    constexpr int SE = 0, SO = 1;
    SLOAD(SE, 0); asm volatile("s_waitcnt vmcnt(0)" ::: "memory"); SWRITE(0, SE); __syncthreads();
    qkt<MODE>(pA0, pA1, K_lds, qr, Qs, r32, hi, cbase); MASK(pA0, pA1, 0); partialSM<MODE>(pA0, pA1, m_reg, mnA, alA);
    SLOAD(SO, 1); if (2 < NT) SLOAD(SE, 2);
    SWAIT(); SWRITE(1, SO); __syncthreads();
    for (int j = 1; j + 1 < NT; j += 2) {
        SBAR(); qkt<MODE>(pB0, pB1, K_lds + SHM_K, qr, Qs, r32, hi, cbase); MASK(pB0, pB1, j);
        finishSM(pA0, pA1, alA, l_reg, pa0, pa1, pa2, pa3); SBAR();
        SLOAD(SO, j + 2 < NT ? j + 2 : NT - 1); SBAR();
        pv_d0(o, vb0, pa0, pa1, pa2, pa3); partialSM<MODE>(pB0, pB1, m_reg, mnB, alB);
        __syncthreads(); SWAIT(); SWRITE(0, SE);
        RESC(alB); __syncthreads();
        SBAR(); qkt<MODE>(pA0, pA1, K_lds, qr, Qs, r32, hi, cbase); MASK(pA0, pA1, j + 1);
        finishSM(pB0, pB1, alB, l_reg, pa0, pa1, pa2, pa3); SBAR();
        if (j + 3 < NT) SLOAD(SE, j + 3); SBAR();
        pv_d0(o, vb0 + SHM_V, pa0, pa1, pa2, pa3); partialSM<MODE>(pA0, pA1, m_reg, mnA, alA);
        __syncthreads(); SWAIT(); SWRITE(1, SO);
        RESC(alA); __syncthreads();
    }
    SBAR(); qkt<MODE>(pB0, pB1, K_lds + SHM_K, qr, Qs, r32, hi, cbase); MASK(pB0, pB1, NT - 1);
    finishSM(pA0, pA1, alA, l_reg, pa0, pa1, pa2, pa3); SBAR();
    pv_d0(o, vb0, pa0, pa1, pa2, pa3); partialSM<MODE>(pB0, pB1, m_reg, mnB, alB);
    __syncthreads(); RESC(alB);
    finishSM(pB0, pB1, alB, l_reg, pa0, pa1, pa2, pa3); SBAR();
    pv_d0(o, vb0 + SHM_V, pa0, pa1, pa2, pa3);
    if (hi == 0) li_l[r32] = l_reg; asm volatile("s_waitcnt lgkmcnt(0)" ::: "memory");
#pragma unroll
    for (int r = 0; r < 16; ++r) { const float rl = __builtin_amdgcn_rcpf(li_l[crow(r, hi)]);
#pragma unroll
        for (int d = 0; d < 4; ++d) o[d][r] *= rl; }
    __syncthreads();
#undef TROW
#undef SLOAD
#undef SWRITE
#undef SWAIT
#undef RESC
#undef MASK
}
}

__device__ __forceinline__ void p0_adaln(Frame& F) {
    LAS float* sil = (LAS float*)(F.lds + 71680); LAS float* red = sil + 3 * 2048;
    const float* c = F.in[I_C]; const float* cc = F.in[I_CCTX];
    for (int i = F.tid; i < 3 * 2048; i += 512) { const int r = i >> 11, k = i & 2047; const float v = r < 2 ? c[r * 2048 + k] : cc[k]; sil[i] = v / (1.0f + expf(-v)); }
    __syncthreads();
    const int c0 = blockIdx.x * 64, kq = F.lane >> 4, cq = F.lane & 15;
    float acc[3][4];
#pragma unroll
    for (int r = 0; r < 3; ++r)
#pragma unroll
        for (int e = 0; e < 4; ++e) acc[r][e] = 0.f;
    const float* wp = F.in[I_WADA] + (size_t)(256 * F.wave + kq) * 12288 + c0 + 4 * cq;
#pragma unroll 8
    for (int it = 0; it < 64; ++it) {
        const int k = 256 * F.wave + 4 * it + kq;
        const f32x4 w = *(const f32x4*)(wp + (size_t)it * 4 * 12288);
        const float s0 = sil[k], s1 = sil[2048 + k], s2 = sil[4096 + k];
#pragma unroll
        for (int e = 0; e < 4; ++e) { acc[0][e] += s0 * w[e]; acc[1][e] += s1 * w[e]; acc[2][e] += s2 * w[e]; }
    }
#pragma unroll
    for (int r = 0; r < 3; ++r)
#pragma unroll
        for (int e = 0; e < 4; ++e) { float v = acc[r][e]; v += __shfl_xor(v, 16); v += __shfl_xor(v, 32); if (kq == 0) red[(F.wave * 3 + r) * 64 + 4 * cq + e] = v; }
    __syncthreads();
    if (F.tid < 192) { const int r = F.tid >> 6, q = F.tid & 63; float s = F.in[I_BADA][c0 + q];
#pragma unroll
        for (int w = 0; w < 8; ++w) s += red[(w * 3 + r) * 64 + q];
        ((float*)(F.ws + WS_MOD))[r * 12288 + c0 + q] = s; }
    __syncthreads();
}
__device__ __forceinline__ unsigned f2bf(float f) { unsigned u = __float_as_uint(f); return (u + 0x7fffu + ((u >> 16) & 1u)) >> 16; }
__device__ __forceinline__ unsigned pk2(float lo, float hi) { return f2bf(lo) | (f2bf(hi) << 16); }
__device__ __forceinline__ void p0_transpose_item(const float* W, int N, int k0, int n0, bf16_t* dst, int dK, bool rope_perm, LAS float* scr, int lane) {
#pragma unroll 8
    for (int i = 0; i < 32; ++i) { const int kk = 2 * i + (lane >> 5); scr[kk * 33 + (lane & 31)] = W[(size_t)(k0 + kk) * N + n0 + (lane & 31)]; }
    LDS_WAIT(); asm volatile("" ::: "memory");
    const int c = lane & 7;
#pragma unroll
    for (int j = 0; j < 4; ++j) { const int n = (lane >> 3) + 8 * j; const int ns = rope_perm ? (16 * ((n >> 2) & 1) + 4 * (n >> 3) + (n & 3)) : n; const LAS float* s = scr + (8 * c) * 33 + ns;
        u32x4 o; o.x = pk2(s[0 * 33], s[1 * 33]); o.y = pk2(s[2 * 33], s[3 * 33]); o.z = pk2(s[4 * 33], s[5 * 33]); o.w = pk2(s[6 * 33], s[7 * 33]);
        *(u32x4*)(dst + (size_t)n * dK + k0 + 8 * c) = o; }
    LDS_WAIT(); asm volatile("" ::: "memory");
}
struct MoeItem { const float* src; unsigned char* dst; int stride; };
constexpr int MOE_IE = 16 * 64;
constexpr int NMOE_X = 96 * MOE_IE, NGATE_IT = 16 * 128;
__device__ __forceinline__ MoeItem moe_item(const float* wg, const float* wu, const float* wd, const float* win, unsigned char* ws, int r, int lane) {
    if (r >= NMOE_X) { const int q = r - NMOE_X, kb = q >> 7, nb = q & 127; MoeItem it; it.stride = INC;
        it.src = win + (size_t)(kb * 128 + (lane >> 5)) * INC + 6144 + nb * 32 + (lane & 31);
        it.dst = ws + WS_WG8 + (size_t)(nb * 32) * DM + kb * 128 + (size_t)(lane >> 3) * DM + 16 * (lane & 7); return it; }
    const int mat = r / MOE_IE, q = r % MOE_IE, e = mat / 3, which = mat % 3, kb = q / 64, nb = q % 64, n0 = nb * 32;
    const float* src = (which == 0 ? wg : (which == 1 ? wu : wd)) + (size_t)e * DM * DFF + (size_t)(kb * 128 + (lane >> 5)) * DFF + n0 + (lane & 31);
    unsigned char* dst;
    if (which < 2) dst = ws + WS_WGUT + ((size_t)(e * 16 + (n0 >> 7)) * 256 + which * 128 + (n0 & 127)) * DM;
    else dst = ws + WS_WDT + ((size_t)e * DM + n0) * DFF;
    MoeItem it; it.stride = DFF; it.src = src; it.dst = dst + kb * 128 + (size_t)(lane >> 3) * DM + 16 * (lane & 7); return it;
}
#define MOE_LOAD(v, it) do { _Pragma("unroll") for (int i_ = 0; i_ < 64; ++i_) v[i_] = __builtin_nontemporal_load((it).src + (size_t)(2 * i_) * (it).stride); } while (0)
#define MOE_PROC(v, it) do { _Pragma("unroll") for (int i_ = 0; i_ < 64; ++i_) { const int k_ = 2 * i_ + (F.lane >> 5); scr[k_ * 32 + ((F.lane & 31) ^ (4 * (k_ >> 4)))] = v[i_]; } \
    LDS_WAIT(); asm volatile("" ::: "memory"); \
    _Pragma("unroll") for (int j_ = 0; j_ < 4; ++j_) { const int c_ = F.lane & 7; const LAS float* s_ = scr + (16 * c_) * 32 + (((F.lane >> 3) + 8 * j_) ^ (4 * c_)); \
        u32x4 o_; o_.x = pk4_fp8(s_[0 * 32] * WSCALE, s_[1 * 32] * WSCALE, s_[2 * 32] * WSCALE, s_[3 * 32] * WSCALE); o_.y = pk4_fp8(s_[4 * 32] * WSCALE, s_[5 * 32] * WSCALE, s_[6 * 32] * WSCALE, s_[7 * 32] * WSCALE); \
        o_.z = pk4_fp8(s_[8 * 32] * WSCALE, s_[9 * 32] * WSCALE, s_[10 * 32] * WSCALE, s_[11 * 32] * WSCALE); o_.w = pk4_fp8(s_[12 * 32] * WSCALE, s_[13 * 32] * WSCALE, s_[14 * 32] * WSCALE, s_[15 * 32] * WSCALE); \
        if (moe_store || o_.x == 0x12345678u) __builtin_nontemporal_store(o_, (u32x4*)((it).dst + (size_t)(8 * j_) * DM)); } \
    LDS_WAIT(); asm volatile("" ::: "memory"); } while (0)
__device__ __forceinline__ void p0_convert(Frame& F, const int parts = 7, const bool moe_store = true) {
    LAS float* scr = (LAS float*)(F.lds + F.wave * 16384);
    const int gw = F.vcu * 8 + F.wave, NGW = F.G * 8;
    constexpr int I_IN = 32 * 320, I_P = 16 * 64, I_O = 32 * 64, I_E = 32 * 64;
    constexpr int NSMALL = I_IN + 2 * I_P + I_O, NMOE = NMOE_X + NGATE_IT;
    if (parts & 1) for (int it = gw; it < NSMALL; it += NGW) {
        int r = it;
        if (r < I_IN) { const int kb = r / 320, nb = r % 320, n0 = nb * 32; const int t = n0 >> 10;
            if (t < 6) p0_transpose_item(F.in[I_WIN], INC, kb * 64, n0, (bf16_t*)(F.ws + WS_WINT) + (size_t)n0 * DM, DM, t == 2 || t == 5, scr, F.lane); continue; } r -= I_IN;
        if (r < I_P) { const int kb = r / 64, nb = r % 64; p0_transpose_item(F.in[I_WPNA], DM, kb * 64, nb * 32, (bf16_t*)(F.ws + WS_WPNAT) + (size_t)nb * 32 * 1024, 1024, false, scr, F.lane); continue; } r -= I_P;
        if (r < I_P) { const int kb = r / 64, nb = r % 64; p0_transpose_item(F.in[I_WPDF], DM, kb * 64, nb * 32, (bf16_t*)(F.ws + WS_WPDFT) + (size_t)nb * 32 * 1024, 1024, false, scr, F.lane); continue; } r -= I_P;
        const int kb = r / 64, nb = r % 64; p0_transpose_item(F.in[I_WOUT], DM, kb * 64, nb * 32, (bf16_t*)(F.ws + WS_WOT) + (size_t)nb * 32 * DM, DM, false, scr, F.lane);
    }
    if (parts & 2) {
        const float* wg = F.in[I_WG]; const float* wu = F.in[I_WU]; const float* wd = F.in[I_WD]; const float* win = F.in[I_WIN];
        float va[64], vb[64];
        const int nmine = (NMOE - gw + NGW - 1) / NGW;
        const int last = gw + (nmine - 1) * NGW;
        MoeItem ia = moe_item(wg, wu, wd, win, F.ws, gw, F.lane), ib = ia;
        MOE_LOAD(va, ia);
        for (int j = 0; j < nmine; j += 2) {
            const int it1 = gw + (j + 1) * NGW, it2 = gw + (j + 2) * NGW;
            ib = moe_item(wg, wu, wd, win, F.ws, it1 <= last ? it1 : last, F.lane); MOE_LOAD(vb, ib);
            MOE_PROC(va, ia);
            ia = moe_item(wg, wu, wd, win, F.ws, it2 <= last ? it2 : last, F.lane); MOE_LOAD(va, ia);
            MOE_PROC(vb, ib);
        }
    }
    const int gt = F.vcu * 512 + F.tid, NGT = F.G * 512;
    if (parts & 4) for (int i = gt; i < 32 * 2048; i += NGT) { const int e = i >> 11, k = i & 2047; const float w = F.in[I_WR][k * 32 + e]; const unsigned hb = f2bf(w); const float lo = w - __uint_as_float(hb << 16);
        ((bf16_t*)(F.ws + WS_WRT))[i] = (bf16_t)hb; ((bf16_t*)(F.ws + WS_WRT))[65536 + i] = (bf16_t)f2bf(lo); }
    if ((parts & 4) && gt < 1024) { const int pos = gt >> 4, i = gt & 15; const float inv = exp2f(-(float)i * (13.287712379549449f / 16.0f)); const float a = (float)pos * inv;
        const float n = rintf(a * 0.15915494309189535f); float rr = fmaf(-n, 6.2831854820251465f, a); rr = fmaf(-n, -1.7484555e-7f, rr);
        ((f32x2*)(F.ws + WS_ROPE))[gt] = (f32x2){__cosf(rr), __sinf(rr)}; }
}

__device__ __forceinline__ void p1_ln_mod(Frame& F) {
    const int gw = F.vcu * 8 + F.wave, NGW = F.G * 8; const float* mod = (const float*)(F.ws + WS_MOD);
    for (int m = gw; m < MTOT; m += NGW) {
        const int b = m / RPB, idx = m % RPB; const float* src; const float* md;
        if (idx < SEQ) { src = F.in[I_X] + (size_t)(b * SEQ + idx) * DM; md = mod + (size_t)b * 12288; } else { src = F.in[I_CTX] + (size_t)(b * CTXL + idx - SEQ) * DM; md = mod + 2 * 12288; }
        const f32x4* xr = (const f32x4*)src + F.lane; f32x4 v[8]; float s = 0.f;
#pragma unroll
        for (int j = 0; j < 8; ++j) { v[j] = xr[64 * j]; s += (v[j][0] + v[j][1]) + (v[j][2] + v[j][3]); }
        const float mean = wave_sum(s) * (1.f / DM); float s2 = 0.f;
#pragma unroll
        for (int j = 0; j < 8; ++j) { v[j] = v[j] - mean; s2 += (v[j][0] * v[j][0] + v[j][1] * v[j][1]) + (v[j][2] * v[j][2] + v[j][3] * v[j][3]); }
        const float rstd = 1.f / sqrtf(wave_sum(s2) * (1.f / DM) + LN_EPS);
        u32x2* o8 = (u32x2*)((bf16_t*)(F.ws + WS_U) + (size_t)m * DM) + F.lane;
#pragma unroll
        for (int j = 0; j < 8; ++j) { const f32x4 sh = ((const f32x4*)md)[F.lane + 64 * j], sc = ((const f32x4*)(md + 2048))[F.lane + 64 * j];
            const f32x4 y = v[j] * rstd * (sc + 1.0f) + sh; u32x2 w; w.x = cvt_pk_bf16(y[0], y[1]); w.y = cvt_pk_bf16(y[2], y[3]); o8[64 * j] = w;
            ((unsigned*)(F.ws + WS_UF8 + (size_t)m * DM))[F.lane + 64 * j] = pk4_fp8(y[0], y[1], y[2], y[3]); }
    }
}

__device__ __forceinline__ void p3_attention(Frame& F) {
    const int c = blockIdx.x; if (c >= 256) return;
    const int xcd = c & 7, j = c >> 3, bh = xcd * 2 + (j >> 4), qb = j & 15, b = bh >> 3, h = bh & 7;
    const bf16_t* KV = (const bf16_t*)(F.ws + WS_KV);
    f32x16 o[4];
    const int tid = F.tid, wid = tid >> 6, lane = tid & 63, r32 = lane & 31, hi = lane >> 5;
#ifndef NO_DIFF
    float lam;
    { float d1 = 0.f, d2 = 0.f;
      for (int i = 0; i < 64; ++i) { d1 += F.in[I_LQ1][i] * F.in[I_LK1][i]; d2 += F.in[I_LQ2][i] * F.in[I_LK2][i]; }
      lam = expf(d1) - expf(d2) + LAM_INIT; }
    {
        const bf16_t* Kh = KV + 2 * (KV_STRIDE / 2) + (size_t)b * RPB * 1024 + h * 128;
        const bf16_t* Vh = KV + 3 * (KV_STRIDE / 2) + (size_t)b * RPB * 1024 + h * 128;
        const bf16_t* Qb = (const bf16_t*)(F.ws + WS_QDF) + (size_t)(b * SEQ + qb * 256) * 1024 + h * 128;
        f32x4* o1s = (f32x4*)((float*)(F.ws + WS_O1S) + ((size_t)c * 512 + tid) * 64);
        attn::attn_pass<1>(Qb, Kh, Vh, RPB / 64, 0, 0, 0, F.lds, o);
#pragma unroll
        for (int d = 0; d < 4; ++d)
#pragma unroll
            for (int q = 0; q < 4; ++q) o1s[d * 4 + q] = (f32x4){o[d][4 * q], o[d][4 * q + 1], o[d][4 * q + 2], o[d][4 * q + 3]};
        attn::attn_pass<1>(Qb + 64, Kh, Vh, RPB / 64, 0, 0, 1, F.lds, o);
        float sw[4];
#pragma unroll
        for (int d = 0; d < 4; ++d) sw[d] = F.in[I_SUBLN][d * 32 + r32] * (1.0f - LAM_INIT);
        bf16_t* od = (bf16_t*)(F.ws + WS_ODF) + (size_t)(b * SEQ + qb * 256 + wid * 32) * 1024 + h * 128 + r32;
#pragma unroll
        for (int r = 0; r < 16; ++r) {
            float dd[4], ss = 0.f;
#pragma unroll
            for (int d = 0; d < 4; ++d) { dd[d] = o1s[d * 4 + (r >> 2)][r & 3] - lam * o[d][r]; ss += dd[d] * dd[d]; }
            ss += __shfl_xor(ss, 1); ss += __shfl_xor(ss, 2); ss += __shfl_xor(ss, 4); ss += __shfl_xor(ss, 8); ss += __shfl_xor(ss, 16);
            const float rs = 1.0f / sqrtf(ss * (1.0f / 128.0f) + RMS_EPS);
            bf16_t* orow = od + (size_t)attn::crow(r, hi) * 1024;
#pragma unroll
            for (int d = 0; d < 4; ++d) orow[d * 32] = (bf16_t)f2bf(dd[d] * rs * sw[d]);
        }
    }
#endif
#ifndef NO_NA
    {
        const int g4 = qb, kr0 = (4 * g4 - 4) < 0 ? 0 : ((4 * g4 - 4) > 52 ? 52 : 4 * g4 - 4);
        LAS float* biasL = (LAS float*)(F.lds + attn::OFF_BIAS);
        for (int i = tid; i < 15 * 32; i += 512) { const int rr = i >> 5, cc = i & 31; biasL[64 + i] = cc < 31 ? F.in[I_RELB][(h * 15 + rr) * 31 + cc] * (1.0f / attn::Cfg<0>::SCALE) : 0.f; }
        __syncthreads();
        const bf16_t* Kh = KV + (size_t)b * RPB * 1024 + h * 128;
        const bf16_t* Vh = KV + 1 * (KV_STRIDE / 2) + (size_t)b * RPB * 1024 + h * 128;
        const bf16_t* Qb = (const bf16_t*)(F.ws + WS_QNA) + (size_t)(b * SEQ + g4 * 256) * 1024 + h * 128;
        attn::attn_pass<0>(Qb, Kh, Vh, 16, kr0, g4, 0, F.lds, o);
        int hi2 = hi, r32b = r32; asm volatile("" : "+v"(hi2), "+v"(r32b));
        bf16_t* od = (bf16_t*)(F.ws + WS_ONA) + (size_t)(b * SEQ + g4 * 256 + wid * 32) * 1024 + h * 128 + r32b;
#pragma unroll
        for (int r = 0; r < 16; ++r) { bf16_t* orow = od + (size_t)attn::crow(r, hi2) * 1024;
#pragma unroll
            for (int d = 0; d < 4; ++d) orow[d * 32] = (bf16_t)f2bf(o[d][r]); }
    }
#endif
}

__device__ __forceinline__ void p6_router(Frame& F) {
    const int t0 = blockIdx.x * 32; if (t0 >= NTOK) return;
    const float* mod = (const float*)(F.ws + WS_MOD);
    const int b = t0 >> 12, lane = F.lane, wave = F.wave, tid = F.tid;
    const bf16_t* ZB = (const bf16_t*)(F.ws + WS_Z); bf16_t* X1 = (bf16_t*)(F.ws + WS_X1);
    bf16_t* U2H = (bf16_t*)(F.ws + WS_U2H); bf16_t* U2L = (bf16_t*)(F.ws + WS_U2L); unsigned* U2F = (unsigned*)(F.ws + WS_U2F);
    {
        f32x4 pw[8], pb[8];
#pragma unroll
        for (int j = 0; j < 8; ++j) { pw[j] = ((const f32x4*)F.in[I_LN1W])[lane + 64 * j]; pb[j] = ((const f32x4*)F.in[I_LN1B])[lane + 64 * j]; }
        for (int rp = 0; rp < 2; ++rp) {
            const int ta = t0 + wave * 4 + 2 * rp;
            f32x4 v2[2][8];
#pragma unroll
            for (int q = 0; q < 2; ++q)
#pragma unroll
                for (int j = 0; j < 8; ++j) { const u32x2 zb = ((const u32x2*)(ZB + (size_t)(ta + q) * DM))[lane + 64 * j]; v2[q][j] = (f32x4){bf_lo(zb.x), bf_hi(zb.x), bf_lo(zb.y), bf_hi(zb.y)}; }
#pragma unroll
            for (int q = 0; q < 2; ++q) {
                const int t = ta + q; f32x4 (&v)[8] = v2[q]; float s = 0.f;
#pragma unroll
                for (int j = 0; j < 8; ++j) s += (v[j][0] + v[j][1]) + (v[j][2] + v[j][3]);
                float mean = wave_sum(s) * (1.f / DM), s2 = 0.f;
#pragma unroll
                for (int j = 0; j < 8; ++j) { v[j] = v[j] - mean; s2 += (v[j][0] * v[j][0] + v[j][1] * v[j][1]) + (v[j][2] * v[j][2] + v[j][3] * v[j][3]); }
                float rstd = 1.f / sqrtf(wave_sum(s2) * (1.f / DM) + LN_EPS);
                s = 0.f;
#pragma unroll
                for (int j = 0; j < 8; ++j) { v[j] = v[j] * rstd * pw[j] + pb[j]; { u32x2 xb; xb.x = cvt_pk_bf16(v[j][0], v[j][1]); xb.y = cvt_pk_bf16(v[j][2], v[j][3]); ((u32x2*)(X1 + (size_t)t * DM))[lane + 64 * j] = xb; } s += (v[j][0] + v[j][1]) + (v[j][2] + v[j][3]); }
                mean = wave_sum(s) * (1.f / DM); s2 = 0.f;
#pragma unroll
                for (int j = 0; j < 8; ++j) { v[j] = v[j] - mean; s2 += (v[j][0] * v[j][0] + v[j][1] * v[j][1]) + (v[j][2] * v[j][2] + v[j][3] * v[j][3]); }
                rstd = 1.f / sqrtf(wave_sum(s2) * (1.f / DM) + LN_EPS);
#pragma unroll
                for (int j = 0; j < 8; ++j) { const f32x4 sh = ((const f32x4*)(mod + (size_t)b * 12288 + 6144))[lane + 64 * j], sc = ((const f32x4*)(mod + (size_t)b * 12288 + 8192))[lane + 64 * j];
                    const f32x4 y = v[j] * rstd * (sc + 1.0f) + sh;
                    u32x2 wh; wh.x = cvt_pk_bf16(y[0], y[1]); wh.y = cvt_pk_bf16(y[2], y[3]);
                    const f32x4 yl = {y[0] - bf_lo(wh.x), y[1] - bf_hi(wh.x), y[2] - bf_lo(wh.y), y[3] - bf_hi(wh.y)};
                    u32x2 wl; wl.x = cvt_pk_bf16(yl[0], yl[1]); wl.y = cvt_pk_bf16(yl[2], yl[3]);
                    ((u32x2*)(U2H + (size_t)t * DM))[lane + 64 * j] = wh; ((u32x2*)(U2L + (size_t)t * DM))[lane + 64 * j] = wl;
                    U2F[(size_t)t * (DM / 4) + lane + 64 * j] = pk4_fp8(y[0], y[1], y[2], y[3]); }
            }
        }
    }
    __syncthreads();
    const bf16_t* WRH = (const bf16_t*)(F.ws + WS_WRT); const bf16_t* WRL = WRH + 65536;
    f32x4 acc[2][2];
#pragma unroll
    for (int a = 0; a < 2; ++a)
#pragma unroll
        for (int n = 0; n < 2; ++n) acc[a][n] = (f32x4){0.f, 0.f, 0.f, 0.f};
    const int fr = lane & 15, fq = lane >> 4;
#pragma unroll 2
    for (int ks = 0; ks < 8; ++ks) {
        const int k0 = wave * 256 + ks * 32 + fq * 8;
        bf16x8 ah[2], al[2], bh[2], bl[2];
#pragma unroll
        for (int a = 0; a < 2; ++a) { ah[a] = *(const bf16x8*)(U2H + (size_t)(t0 + 16 * a + fr) * DM + k0); al[a] = *(const bf16x8*)(U2L + (size_t)(t0 + 16 * a + fr) * DM + k0); }
#pragma unroll
        for (int n = 0; n < 2; ++n) { bh[n] = *(const bf16x8*)(WRH + (size_t)(16 * n + fr) * DM + k0); bl[n] = *(const bf16x8*)(WRL + (size_t)(16 * n + fr) * DM + k0); }
#pragma unroll
        for (int a = 0; a < 2; ++a)
#pragma unroll
            for (int n = 0; n < 2; ++n) {
                acc[a][n] = __builtin_amdgcn_mfma_f32_16x16x32_bf16(ah[a], bh[n], acc[a][n], 0, 0, 0);
                acc[a][n] = __builtin_amdgcn_mfma_f32_16x16x32_bf16(ah[a], bl[n], acc[a][n], 0, 0, 0);
                acc[a][n] = __builtin_amdgcn_mfma_f32_16x16x32_bf16(al[a], bh[n], acc[a][n], 0, 0, 0);
            }
    }
    LAS float* red = (LAS float*)F.lds;
    LAS float* lg = red + 8 * 1024;
    LAS int* aE = (LAS int*)(lg + 1024); LAS int* aP = aE + 128; LAS float* aW = (LAS float*)(aP + 128);
#pragma unroll
    for (int a = 0; a < 2; ++a)
#pragma unroll
        for (int n = 0; n < 2; ++n)
#pragma unroll
            for (int i = 0; i < 4; ++i) red[wave * 1024 + (16 * a + 4 * fq + i) * 32 + 16 * n + fr] = acc[a][n][i];
    __syncthreads();
    for (int i = tid; i < 1024; i += 512) { float s = F.in[I_BR][i & 31];
#pragma unroll
        for (int w = 0; w < 8; ++w) s += red[w * 1024 + i];
        lg[i] = s; }
    __syncthreads();
    for (int pass = 0; pass < 2; ++pass) {
        const int row = pass * 16 + (tid >> 5), e = tid & 31;
        float v = lg[row * 32 + e]; float tl[4]; int te[4];
#pragma unroll
        for (int k = 0; k < 4; ++k) {
            float bv = v; int bi = e;
#pragma unroll
            for (int o = 16; o >= 1; o >>= 1) { const float ov = __shfl_xor(bv, o); const int oi = __shfl_xor(bi, o); if (ov > bv || (ov == bv && oi < bi)) { bv = ov; bi = oi; } }
            tl[k] = bv; te[k] = bi; if (e == bi) v = -INFINITY;
        }
        if (e == 0) { const float e1 = expf(tl[1] - tl[0]), e2 = expf(tl[2] - tl[0]), e3 = expf(tl[3] - tl[0]); const float inv = 1.0f / (1.0f + e1 + e2 + e3);
            aE[row * 4 + 0] = te[0]; aE[row * 4 + 1] = te[1]; aE[row * 4 + 2] = te[2]; aE[row * 4 + 3] = te[3];
            aW[row * 4 + 0] = inv; aW[row * 4 + 1] = e1 * inv; aW[row * 4 + 2] = e2 * inv; aW[row * 4 + 3] = e3 * inv; }
    }
    __syncthreads();
    LAS int* lc = (LAS int*)(aW + 128);
    if (tid < 32) lc[tid] = 0;
    __syncthreads();
    int myE = 0, myR = 0;
    if (tid < 128) { myE = aE[tid]; myR = __hip_atomic_fetch_add(lc + myE, 1, __ATOMIC_RELAXED, __HIP_MEMORY_SCOPE_WORKGROUP); }
    __syncthreads();
    if (tid < 32) { const int n = lc[tid]; lc[32 + tid] = n > 0 ? (int)__hip_atomic_fetch_add(F.ctl + CW_CNT + 64 * tid, (unsigned)n, RLX_AGENT) : 0; }
    __syncthreads();
    if (tid < 128) { const int pos = lc[32 + myE] + myR;
        ((int*)(F.ws + WS_TOKL))[myE * NTOK + pos] = t0 + (tid >> 2);
        ((int*)(F.ws + WS_ASG_E))[t0 * 4 + tid] = myE; ((int*)(F.ws + WS_ASG_P))[t0 * 4 + tid] = pos; ((float*)(F.ws + WS_ASG_W))[t0 * 4 + tid] = aW[tid]; }
}

__device__ __forceinline__ MoeTabs moe_tables(Frame& F) {
    LAS int* tab = (LAS int*)(F.lds + TAB_OFF);
    if (F.tid < 32) tab[320 + F.tid] = (int)__hip_atomic_load(F.ctl + CW_CNT + 64 * F.tid, RLX_AGENT);
    __syncthreads();
    if (F.tid == 0) { int nt = 0;
        for (int e = 0; e < NEXP; ++e) { const int n = (tab[320 + e] + 255) >> 8; tab[352 + e] = nt; for (int r = 0; r < n; ++r) { tab[nt] = e; tab[160 + nt] = r; ++nt; } }
        tab[384] = nt; }
    __syncthreads();
    MoeTabs tb; tb.tile_e = tab; tb.tile_r = tab + 160; tb.tokl = tab + 512; tb.ntiles = tab[384];
    return tb;
}

__device__ __forceinline__ void p9_final(Frame& F) {
    const LAS int* tab = (const LAS int*)(F.lds + TAB_OFF);
    const int gw = F.vcu * 8 + F.wave, NGW = F.G * 8, lane = F.lane; const float* mod = (const float*)(F.ws + WS_MOD);
    const bf16_t* X1 = (const bf16_t*)(F.ws + WS_X1); const bf16_t* Y = (const bf16_t*)(F.ws + WS_Y);
    for (int t = gw; t < NTOK; t += NGW) {
        const int b = t >> 12;
        const i32x4 ae = ((const i32x4*)(F.ws + WS_ASG_E))[t], ap = ((const i32x4*)(F.ws + WS_ASG_P))[t]; const f32x4 aw = ((const f32x4*)(F.ws + WS_ASG_W))[t];
        const u32x2* yr[4];
#pragma unroll
        for (int k = 0; k < 4; ++k) yr[k] = (const u32x2*)(Y + ((size_t)tab[352 + ae[k]] * 256 + ap[k]) * DM) + lane;
        u32x2 q[4][8]; f32x4 x1[8];
#pragma unroll
        for (int k = 0; k < 4; ++k)
#pragma unroll
            for (int j = 0; j < 8; ++j) q[k][j] = yr[k][64 * j];
#pragma unroll
        for (int j = 0; j < 8; ++j) { const u32x2 xb = ((const u32x2*)(X1 + (size_t)t * DM))[lane + 64 * j]; x1[j] = (f32x4){bf_lo(xb.x), bf_hi(xb.x), bf_lo(xb.y), bf_hi(xb.y)}; }
        float s = 0.f; f32x4 v[8];
#pragma unroll
        for (int j = 0; j < 8; ++j) { f32x4 y = {0.f, 0.f, 0.f, 0.f};
#pragma unroll
            for (int k = 0; k < 4; ++k) { const float w = aw[k]; y[0] += w * bf_lo(q[k][j].x); y[1] += w * bf_hi(q[k][j].x); y[2] += w * bf_lo(q[k][j].y); y[3] += w * bf_hi(q[k][j].y); }
            v[j] = x1[j] * DN_ALPHA + ((const f32x4*)(mod + (size_t)b * 12288 + 10240))[lane + 64 * j] * y; s += (v[j][0] + v[j][1]) + (v[j][2] + v[j][3]); }
        const float mean = wave_sum(s) * (1.f / DM); float s2 = 0.f;
#pragma unroll
        for (int j = 0; j < 8; ++j) { v[j] = v[j] - mean; s2 += (v[j][0] * v[j][0] + v[j][1] * v[j][1]) + (v[j][2] * v[j][2] + v[j][3] * v[j][3]); }
        const float rstd = 1.f / sqrtf(wave_sum(s2) * (1.f / DM) + LN_EPS);
#pragma unroll
        for (int j = 0; j < 8; ++j) ((f32x4*)(F.out + (size_t)t * DM))[lane + 64 * j] = v[j] * rstd * ((const f32x4*)F.in[I_LN2W])[lane + 64 * j] + ((const f32x4*)F.in[I_LN2B])[lane + 64 * j];
    }
}

constexpr int NPHASE = 10;
struct Args { const float* in[28]; float* out; unsigned char* ws; int ph_lo, ph_hi; };
__global__ void __launch_bounds__(512, 2) fwd(Args args) {
    extern __shared__ __attribute__((aligned(16))) unsigned char lds_raw[];
    Frame F;
    F.lds = (LAS unsigned char*)lds_raw;
    F.MISC = (volatile LAS unsigned*)(F.lds + MISC_OFF);
    F.tid = threadIdx.x; F.lane = F.tid & 63; F.wave = __builtin_amdgcn_readfirstlane(F.tid >> 6);
    F.G = gridDim.x; { const int bx = blockIdx.x; F.vcu = (F.G % 8 == 0) ? (bx % 8) * (F.G / 8) + bx / 8 : bx; }
    F.ws = args.ws; F.ctl = (gu32*)(args.ws + WS_CTL); F.out = args.out;
#pragma unroll
    for (int i = 0; i < 28; ++i) F.in[i] = args.in[i];
    for (int u = F.tid; u < 64; u += 512) ((LAS unsigned*)(F.lds + MISC_OFF))[u] = 0u;
    __syncthreads();
    const int lo = args.ph_lo, hi = args.ph_hi;
    const bool use_bar = (hi - lo) > 1;
    XcdBarrier bar; bar.bar = (unsigned*)(F.ctl + CW_BAR); bar.x = 0; bar.st = nullptr;
    if (use_bar) bar = xcd_barrier_post((unsigned*)(F.ctl + CW_BAR), F.MISC + 8);
#ifndef PH_MASK
#define PH_MASK 0x3ff
#endif
#define IN(k) (((PH_MASK >> (k)) & 1) && lo <= (k) && (k) < hi)
#define SEAM(k) do { if (IN(k) && IN((k) + 1)) xcd_barrier(bar); } while (0)

    if (IN(0)) { if (blockIdx.x < 192) p0_adaln(F); p0_convert(F); } SEAM(0);
    if (IN(1)) { p1_ln_mod(F); } SEAM(1);
    if (IN(2)) { InprojOrder S{(int)blockIdx.x, F.G, (const char*)(F.ws + WS_U), (const char*)(F.ws + WS_WINT)}; EpiInprojW E{F.ws, (const f32x2*)(F.ws + WS_ROPE), F.lds + TAB_OFF};
        pg8::gemm_phase<EpiInprojW, InprojOrder, false>(F.lds, DM, S, E);
        GateOrder S2{(int)blockIdx.x, F.G, (const char*)(F.ws + WS_UF8), (const char*)(F.ws + WS_WG8)}; EpiGate E2{(bf16_t*)(F.ws + WS_GNA), (bf16_t*)(F.ws + WS_GDF), F.lds + TAB_OFF};
        pg8::gemm_phase<EpiGate, GateOrder, false, true>(F.lds, DM / 2, S2, E2); } SEAM(2);
    if (IN(3)) { p3_attention(F); } SEAM(3);
    if (IN(4)) { MergeOrder S{(int)blockIdx.x, (const char*)(F.ws + WS_ONA), (const char*)(F.ws + WS_ODF), (const char*)(F.ws + WS_WPNAT), (const char*)(F.ws + WS_WPDFT)};
        EpiMerge E{(const bf16_t*)(F.ws + WS_GNA), (const bf16_t*)(F.ws + WS_GDF), (bf16_t*)(F.ws + WS_YPRE), F.lds + TAB_OFF};
        pg8::gemm_phase<EpiMerge, MergeOrder, false>(F.lds, 1024, S, E); } SEAM(4);
    if (IN(5)) { OutOrder S{(int)blockIdx.x, (const char*)(F.ws + WS_YPRE), (const char*)(F.ws + WS_WOT)}; EpiOut E{F.in[I_X], (const float*)(F.ws + WS_MOD), (bf16_t*)(F.ws + WS_Z), F.lds + TAB_OFF};
        pg8::gemm_phase<EpiOut, OutOrder, false>(F.lds, DM, S, E); } SEAM(5);
    if (IN(6)) { p6_router(F); } SEAM(6);
    if (IN(7)) { const MoeTabs tb = moe_tables(F);
        Moe1Order S{(int)blockIdx.x, tb, (const char*)(F.ws + WS_U2F), (const char*)(F.ws + WS_WGUT)};
        { LAS int* tab = (LAS int*)(F.lds + TAB_OFF); const int* tokl = (const int*)(F.ws + WS_TOKL);
          for (int i = 0; i < 10; ++i) { Unit u; if (!S.next(i, u)) break; const int tile = u.row0 >> 8, e = u.tag, r0 = tab[160 + tile] * 256, n = tab[320 + e];
              for (int r = F.tid; r < 256; r += 512) tab[512 + i * 256 + r] = (r0 + r < n) ? tokl[e * NTOK + r0 + r] : 0; }
          __syncthreads(); }
        EpiMoe1 E{F.in[I_BG], F.in[I_BU], F.ws + WS_H};
        pg8::gemm_phase<EpiMoe1, Moe1Order, true, true>(F.lds, DM / 2, S, E); } SEAM(7);
    if (IN(8)) { const MoeTabs tb = moe_tables(F);
        Moe2Order S{(int)blockIdx.x, tb, (const char*)(F.ws + WS_H), (const char*)(F.ws + WS_WDT)}; EpiMoe2 E{F.in[I_BD], (bf16_t*)(F.ws + WS_Y), F.lds + TAB_OFF + 2048};
        pg8::gemm_phase<EpiMoe2, Moe2Order, false, true>(F.lds, DFF / 2, S, E); } SEAM(8);
    if (IN(9)) { (void)moe_tables(F); p9_final(F); }
#undef IN
#undef SEAM
}

extern "C" void kernel_launch(void* const* d_in, const int* in_sizes, int n_in, void* d_out, int out_size, void* d_ws, size_t ws_size, hipStream_t stream) {
    static int grid = 0;
    if (grid == 0) {
        if (n_in != 28 || out_size != NTOK * DM || ws_size < WS_END) { fprintf(stderr, "kernel_launch: unexpected shapes (n_in %d, out %d, ws %zu < %zu)\n", n_in, out_size, ws_size, (size_t)WS_END); grid = -1; return; }
        int dev = 0, cus = 0;
        if (hipGetDevice(&dev) != hipSuccess || hipDeviceGetAttribute(&cus, hipDeviceAttributeMultiprocessorCount, dev) != hipSuccess) { grid = -1; return; }
        if (hipFuncSetAttribute((const void*)fwd, hipFuncAttributeMaxDynamicSharedMemorySize, LDS_BYTES) != hipSuccess) { fprintf(stderr, "kernel_launch: hipFuncSetAttribute failed\n"); grid = -1; return; }
        int per_cu = 0; (void)hipOccupancyMaxActiveBlocksPerMultiprocessor(&per_cu, (const void*)fwd, 512, LDS_BYTES); (void)hipGetLastError();
        if (per_cu < 1) fprintf(stderr, "kernel_launch: occupancy query reports %d\n", per_cu);
        grid = cus < 256 ? cus : 256;
        if (grid != 256) fprintf(stderr, "kernel_launch: %d CUs; this kernel is built for 256\n", cus);
    }
    if (grid < 0) return;
    (void)hipMemsetAsync((char*)d_ws + WS_CTL, 0, CTL_ZERO_BYTES, stream);
    Args a{};
    for (int i = 0; i < 28; ++i) a.in[i] = (const float*)d_in[i];
    a.out = (float*)d_out; a.ws = (unsigned char*)d_ws;
#if MK_SPLIT
#ifndef PROBE_DUP
#define PROBE_DUP -1
#endif
    for (int p = 0; p < NPHASE; ++p) { a.ph_lo = p; a.ph_hi = p + 1; hipLaunchKernelGGL(fwd, dim3(grid), dim3(512), LDS_BYTES, stream, a);
        if (p == PROBE_DUP) hipLaunchKernelGGL(fwd, dim3(grid), dim3(512), LDS_BYTES, stream, a); }
#else
    a.ph_lo = 0; a.ph_hi = NPHASE; hipLaunchKernelGGL(fwd, dim3(grid), dim3(512), LDS_BYTES, stream, a);
#endif
}
```
